# Optimizing an MI355X kernel written in HIP

```python
import jax, jax.numpy as jnp
from jax import lax
import numpy as np


D_MODEL = 1024
BATCH = 16
SEQ = 2048
DEPTH = 4

GRID_W = 64
CTX_LEN = 256
HEAD_DIM = 64
HQ_A = D_MODEL // (2 * HEAD_DIM)
HKV_A = HQ_A // 4
HQ_B = D_MODEL // (2 * HEAD_DIM)
HKV_B = HQ_B // 4
Q_BLOCK = 128
WINDOW = 128
KEY_SPAN = Q_BLOCK + 2 * WINDOW
ROPE_THETA = 10000.0
ROPE_AXIS_DIM = HEAD_DIM // 2
ATT_WIDTHS = (HQ_A * HEAD_DIM, HKV_A * HEAD_DIM, HKV_A * HEAD_DIM,
              HQ_B * HEAD_DIM, HKV_B * HEAD_DIM, HKV_B * HEAD_DIM)
ATT_SPLITS = tuple(int(s) for s in np.cumsum(ATT_WIDTHS)[:-1])
ATT_IN_WIDTH = sum(ATT_WIDTHS)
ATT_OUT_WIDTH = (HQ_A + HQ_B) * HEAD_DIM
CONV_DIM = D_MODEL
CONV_WIDTH = 3
N_EXPERTS = 16
EXPERT_FF = D_MODEL
CAPACITY_FACTOR = 2
N_ADA = 6
N_ATT_LAYERS = (DEPTH + 1) // 2
N_CONV_LAYERS = DEPTH // 2
EPS = 1e-6
NEG_INF = -1e30

kernel_name = 'hybrid_dit_attn_window_shortconv_ecmoe'


def _rmsnorm(x, g):
    xf = x.astype(jnp.float32)
    xf = xf * lax.rsqrt(jnp.mean(xf * xf, axis=-1, keepdims=True) + EPS)
    return xf.astype(x.dtype) * g


def _modulate(h, shift, scale):
    return h * (1.0 + scale) + shift


def _axial_rope_tables(n_tokens):
    rows = n_tokens // GRID_W
    row = jnp.repeat(jnp.arange(rows, dtype=jnp.float32), GRID_W)
    col = jnp.tile(jnp.arange(GRID_W, dtype=jnp.float32), rows)
    inv_freq = ROPE_THETA ** (-jnp.arange(0, ROPE_AXIS_DIM, 2, dtype=jnp.float32) / ROPE_AXIS_DIM)
    ang_r = row[:, None] * inv_freq[None, :]
    ang_c = col[:, None] * inv_freq[None, :]
    return (jnp.cos(ang_r), jnp.sin(ang_r), jnp.cos(ang_c), jnp.sin(ang_c))


def _rotate(x, cos, sin):
    a, b = jnp.split(x, 2, axis=-1)
    cos = cos[None, :, None, :]
    sin = sin[None, :, None, :]
    return jnp.concatenate([a * cos - b * sin, a * sin + b * cos], axis=-1)


def _apply_axial_rope(x, rope):
    cos_r, sin_r, cos_c, sin_c = rope
    xr, xc = jnp.split(x.astype(jnp.float32), 2, axis=-1)
    return jnp.concatenate([_rotate(xr, cos_r, sin_r), _rotate(xc, cos_c, sin_c)], axis=-1).astype(x.dtype)


def _project_heads(h, w_in):
    p = h @ w_in
    qa, ka, va, qb, kb, vb = jnp.split(p, ATT_SPLITS, axis=-1)
    B, n = h.shape[0], h.shape[1]
    shp = lambda t: t.reshape(B, n, -1, HEAD_DIM)
    return shp(qa), shp(ka), shp(va), shp(qb), shp(kb), shp(vb)


def _sink_column(sink, hkv, g, B, nq):
    return jnp.broadcast_to(sink.astype(jnp.float32).reshape(1, hkv, g, 1, 1), (B, hkv, g, nq, 1))


def _global_attention_latent(q, k, v, k_ctx, v_ctx):
    B, n, hq, hd = q.shape
    hkv = k.shape[2]
    g = hq // hkv
    nb = n // Q_BLOCK
    qblk = (q * hd ** -0.5).reshape(B, nb, Q_BLOCK, hkv, g, hd).transpose(1, 0, 2, 3, 4, 5)

    def one_block(qb):
        s = jnp.concatenate([jnp.einsum('bqhgd,bkhd->bhgqk', qb, k),
                             jnp.einsum('bqhgd,bkhd->bhgqk', qb, k_ctx)], axis=-1)
        p = jax.nn.softmax(s.astype(jnp.float32), axis=-1).astype(v.dtype)
        return (jnp.einsum('bhgqk,bkhd->bqhgd', p[..., :n], v)
                + jnp.einsum('bhgqk,bkhd->bqhgd', p[..., n:], v_ctx))

    o = lax.map(one_block, qblk)
    return o.transpose(1, 0, 2, 3, 4, 5).reshape(B, n, hq * hd)


def _window_attention_latent(q, k, v, k_ctx, v_ctx, sink):
    B, n, hq, hd = q.shape
    hkv = k.shape[2]
    g = hq // hkv
    nb = n // Q_BLOCK
    qblk = (q * hd ** -0.5).reshape(B, nb, Q_BLOCK, hkv, g, hd).transpose(1, 0, 2, 3, 4, 5)
    k_pad = jnp.pad(k, ((0, 0), (WINDOW, WINDOW), (0, 0), (0, 0)))
    v_pad = jnp.pad(v, ((0, 0), (WINDOW, WINDOW), (0, 0), (0, 0)))
    a_idx = jnp.arange(Q_BLOCK)[:, None]
    b_idx = jnp.arange(KEY_SPAN)[None, :]
    band = (b_idx >= a_idx) & (b_idx <= a_idx + 2 * WINDOW)
    sink_col = _sink_column(sink, hkv, g, B, Q_BLOCK)
    L = k_ctx.shape[1]

    def one_block(args):
        blk, qb = args
        start = blk * Q_BLOCK
        kw = lax.dynamic_slice_in_dim(k_pad, start, KEY_SPAN, axis=1)
        vw = lax.dynamic_slice_in_dim(v_pad, start, KEY_SPAN, axis=1)
        j = start - WINDOW + jnp.arange(KEY_SPAN)
        mask = band & ((j >= 0) & (j < n))[None, :]
        s_w = jnp.einsum('bqhgd,bkhd->bhgqk', qb, kw).astype(jnp.float32)
        s_w = jnp.where(mask, s_w, NEG_INF)
        s_c = jnp.einsum('bqhgd,bkhd->bhgqk', qb, k_ctx).astype(jnp.float32)
        s = jnp.concatenate([s_w, s_c, sink_col], axis=-1)
        p = jax.nn.softmax(s, axis=-1).astype(v.dtype)
        return (jnp.einsum('bhgqk,bkhd->bqhgd', p[..., :KEY_SPAN], vw)
                + jnp.einsum('bhgqk,bkhd->bqhgd', p[..., KEY_SPAN:KEY_SPAN + L], v_ctx))

    o = lax.map(one_block, (jnp.arange(nb), qblk))
    return o.transpose(1, 0, 2, 3, 4, 5).reshape(B, n, hq * hd)


def _context_attention(q, k, v, sink=None):
    B, L, hq, hd = q.shape
    hkv = k.shape[2]
    g = hq // hkv
    qg = (q * hd ** -0.5).reshape(B, L, hkv, g, hd)
    s = jnp.einsum('bqhgd,bkhd->bhgqk', qg, k).astype(jnp.float32)
    if sink is not None:
        s = jnp.concatenate([s, _sink_column(sink, hkv, g, B, L)], axis=-1)
    p = jax.nn.softmax(s, axis=-1).astype(v.dtype)[..., :L]
    return jnp.einsum('bhgqk,bkhd->bqhgd', p, v).reshape(B, L, hq * hd)


def _hybrid_attention(h, hc, w_in, w_out, qg_a, kg_a, qg_b, kg_b, sink, rope, need_ctx):
    qa, ka, va, qb, kb, vb = _project_heads(h, w_in)
    qac, kac, vac, qbc, kbc, vbc = _project_heads(hc, w_in)
    qa = _apply_axial_rope(_rmsnorm(qa, qg_a), rope)
    ka = _apply_axial_rope(_rmsnorm(ka, kg_a), rope)
    qb = _apply_axial_rope(_rmsnorm(qb, qg_b), rope)
    kb = _apply_axial_rope(_rmsnorm(kb, kg_b), rope)
    kac = _rmsnorm(kac, kg_a)
    kbc = _rmsnorm(kbc, kg_b)
    o_a = _global_attention_latent(qa, ka, va, kac, vac)
    o_b = _window_attention_latent(qb, kb, vb, kbc, vbc, sink)
    y = jnp.concatenate([o_a, o_b], axis=-1) @ w_out
    yc = None
    if need_ctx:
        oc_a = _context_attention(_rmsnorm(qac, qg_a), kac, vac)
        oc_b = _context_attention(_rmsnorm(qbc, qg_b), kbc, vbc, sink)
        yc = jnp.concatenate([oc_a, oc_b], axis=-1) @ w_out
    return y, yc


def _short_conv(h, w_in, conv_k, conv_b, w_out):
    bg, cg, v = jnp.split(h @ w_in, 3, axis=-1)
    u = cg * v
    y = lax.conv_general_dilated(u, conv_k[:, None, :].astype(u.dtype), window_strides=(1,),
                                 padding=((CONV_WIDTH // 2, CONV_WIDTH // 2),),
                                 dimension_numbers=('NWC', 'WIO', 'NWC'),
                                 feature_group_count=u.shape[-1]) + conv_b
    return (bg * y) @ w_out


def _expert_choice_moe(h, router_w, w_gate, w_up, w_down):
    B, n, _ = h.shape
    cap = CAPACITY_FACTOR * n // N_EXPERTS
    aff = jax.nn.softmax(jnp.einsum('bnd,de->bne', h, router_w).astype(jnp.float32), axis=-1)
    gate, idx = lax.top_k(aff.transpose(0, 2, 1), cap)
    bidx = jnp.arange(B)[:, None, None]
    xe = h[bidx, idx]
    hid = jax.nn.silu(jnp.einsum('becd,edf->becf', xe, w_gate)) * jnp.einsum('becd,edf->becf', xe, w_up)
    ye = jnp.einsum('becf,efd->becd', hid, w_down) * gate[..., None].astype(h.dtype)
    return jnp.zeros_like(h).at[bidx, idx].add(ye)


def setup_inputs(seed: int = 0) -> dict:
    key = jax.random.key(seed)
    ks = jax.random.split(key, 24)
    f32 = jnp.float32
    nrm = lambda k, shape, s: jax.random.normal(k, shape, f32) * s
    D, F = D_MODEL, EXPERT_FF
    return {
        'x': nrm(ks[0], (BATCH, SEQ, D), 1.0),
        'c': nrm(ks[1], (BATCH, D), 1.0),
        'ctx': nrm(ks[2], (BATCH, CTX_LEN, D), 1.0),
        'c_ctx': nrm(ks[3], (D,), 1.0),
        'ada_w': nrm(ks[4], (DEPTH, D, N_ADA * D), 0.5 * D ** -0.5),
        'ada_b': nrm(ks[5], (DEPTH, N_ADA * D), 0.02),
        'norm1_g': 1.0 + nrm(ks[6], (DEPTH, D), 0.1),
        'norm2_g': 1.0 + nrm(ks[7], (DEPTH, D), 0.1),
        'attn_w_in': nrm(ks[8], (N_ATT_LAYERS, D, ATT_IN_WIDTH), D ** -0.5),
        'attn_w_out': nrm(ks[9], (N_ATT_LAYERS, ATT_OUT_WIDTH, D), ATT_OUT_WIDTH ** -0.5),
        'qnorm_a': 1.0 + nrm(ks[10], (N_ATT_LAYERS, HEAD_DIM), 0.1),
        'knorm_a': 1.0 + nrm(ks[11], (N_ATT_LAYERS, HEAD_DIM), 0.1),
        'qnorm_b': 1.0 + nrm(ks[12], (N_ATT_LAYERS, HEAD_DIM), 0.1),
        'knorm_b': 1.0 + nrm(ks[13], (N_ATT_LAYERS, HEAD_DIM), 0.1),
        'sink_b': nrm(ks[14], (N_ATT_LAYERS, HQ_B), 0.5),
        'conv_w_in': nrm(ks[15], (N_CONV_LAYERS, D, 3 * CONV_DIM), D ** -0.5),
        'conv_k': nrm(ks[16], (N_CONV_LAYERS, CONV_WIDTH, CONV_DIM), CONV_WIDTH ** -0.5),
        'conv_b': nrm(ks[17], (N_CONV_LAYERS, CONV_DIM), 0.02),
        'conv_w_out': nrm(ks[18], (N_CONV_LAYERS, CONV_DIM, D), CONV_DIM ** -0.5),
        'router_w': nrm(ks[19], (DEPTH, D, N_EXPERTS), D ** -0.5),
        'moe_w_gate': nrm(ks[20], (DEPTH, N_EXPERTS, D, F), D ** -0.5),
        'moe_w_up': nrm(ks[21], (DEPTH, N_EXPERTS, D, F), D ** -0.5),
        'moe_w_down': nrm(ks[22], (DEPTH, N_EXPERTS, F, D), F ** -0.5),
    }


def reference(x, c, ctx, c_ctx, ada_w, ada_b, norm1_g, norm2_g, attn_w_in, attn_w_out,
              qnorm_a, knorm_a, qnorm_b, knorm_b, sink_b, conv_w_in, conv_k, conv_b, conv_w_out,
              router_w, moe_w_gate, moe_w_up, moe_w_down):
    rope = _axial_rope_tables(x.shape[1])
    silu_c = jax.nn.silu(c)
    silu_cc = jax.nn.silu(c_ctx)
    for i in range(DEPTH):
        need_ctx = i < DEPTH - 1
        j = i // 2
        mod = silu_c @ ada_w[i] + ada_b[i]
        mod_c = silu_cc @ ada_w[i] + ada_b[i]
        sh1, sc1, g1, sh2, sc2, g2 = [m[:, None, :] for m in jnp.split(mod, N_ADA, axis=-1)]
        sh1c, sc1c, g1c, sh2c, sc2c, g2c = jnp.split(mod_c, N_ADA, axis=-1)
        h = _modulate(_rmsnorm(x, norm1_g[i]), sh1, sc1)
        hc = _modulate(_rmsnorm(ctx, norm1_g[i]), sh1c, sc1c)
        if i % 2 == 0:
            y, yc = _hybrid_attention(h, hc, attn_w_in[j], attn_w_out[j], qnorm_a[j], knorm_a[j],
                                      qnorm_b[j], knorm_b[j], sink_b[j], rope, need_ctx)
        else:
            y = _short_conv(h, conv_w_in[j], conv_k[j], conv_b[j], conv_w_out[j])
            yc = _short_conv(hc, conv_w_in[j], conv_k[j], conv_b[j], conv_w_out[j]) if need_ctx else None
        x = x + g1 * y
        x = x + g2 * _expert_choice_moe(_modulate(_rmsnorm(x, norm2_g[i]), sh2, sc2),
                                        router_w[i], moe_w_gate[i], moe_w_up[i], moe_w_down[i])
        if need_ctx:
            ctx = ctx + g1c * yc
            ctx = ctx + g2c * _expert_choice_moe(_modulate(_rmsnorm(ctx, norm2_g[i]), sh2c, sc2c),
                                                 router_w[i], moe_w_gate[i], moe_w_up[i], moe_w_down[i])
    return x
```

```cpp
#include <hip/hip_runtime.h>
#include <hip/hip_bf16.h>
#include <cstdio>
#include <cstdint>
#include <cmath>

#ifndef MK_PER_PHASE
#define MK_PER_PHASE 0
#endif
#ifndef PG8_SP2
#define PG8_SP2 true
#endif
#ifndef ATT_NAIVE
#define ATT_NAIVE 0
#endif

#define GAS __attribute__((address_space(1)))
#define LAS __attribute__((address_space(3)))
typedef unsigned short bf16_t;
typedef short bf16x8 __attribute__((ext_vector_type(8)));
typedef float f32x4 __attribute__((ext_vector_type(4)));
typedef float f32x2 __attribute__((ext_vector_type(2)));
typedef unsigned u32x4 __attribute__((ext_vector_type(4)));
typedef unsigned u32x2 __attribute__((ext_vector_type(2)));
typedef GAS unsigned gu32;
#define RLX_AGENT __ATOMIC_RELAXED, __HIP_MEMORY_SCOPE_AGENT

constexpr int D = 1024, NB = 16, SEQ = 2048, CTXL = 256, DEPTH = 4, HD = 64;
constexpr int NLAT = NB * SEQ, NCTX = NB * CTXL, NROWS = NLAT + NCTX;
constexpr int NE = 16, KVLEN = SEQ + CTXL  , KVP = 256  ;
constexpr int NSLOT_LAT = NB * NE * 256, NSLOT_ALL = NSLOT_LAT + NB * NE * 32;
constexpr float EPS = 1e-6f;
constexpr float C2 = 0.125f * 1.4426950408889634f;
constexpr float LOG2E = 1.4426950408889634f;

constexpr size_t MiB = 1u << 20;
constexpr size_t WS_CTL = 0, CTL_ZERO_BYTES = 64 * 1024;
constexpr size_t WS_MOD = 1 * MiB;
constexpr size_t WS_ROPE = 3 * MiB;
constexpr size_t WS_GAM = WS_ROPE + 8192;
constexpr size_t WS_IDX = 3 * MiB + 64 * 1024;
constexpr size_t WS_GATE = WS_IDX + 512 * 1024;
constexpr size_t WS_TOKSLOT = 4 * MiB + 512 * 1024;
constexpr size_t WS_AFF = 6 * MiB;
constexpr size_t WS_XCTX = 9 * MiB;
constexpr size_t WS_WAIN = 25 * MiB;
constexpr size_t WS_WAOUT = 31 * MiB;
constexpr size_t WS_WCIN = 35 * MiB;
constexpr size_t WS_WCOUT = 47 * MiB;
constexpr size_t WS_WUP = 51 * MiB;
constexpr size_t WS_WDN = 307 * MiB;
constexpr size_t WS_H = 435 * MiB;
constexpr size_t WS_MIX = 507 * MiB;
constexpr size_t WS_Q = WS_MIX, WS_K = WS_MIX + 72 * MiB, WS_V = WS_K + 18 * MiB;
constexpr size_t WS_BG = WS_MIX, WS_U = WS_MIX + 72 * MiB;
constexpr size_t WS_HID = WS_MIX;
constexpr size_t WS_Y = 651 * MiB;
constexpr size_t WS_X = 795 * MiB;
constexpr size_t WS_END = 867 * MiB;
static_assert(WS_TOKSLOT + (size_t)16 * NROWS * 2 <= WS_AFF && WS_AFF + (size_t)NROWS * 16 * 4 <= WS_XCTX && WS_GATE + (size_t)NSLOT_ALL * 4 <= WS_TOKSLOT, "ws map");
static_assert(WS_V + (size_t)NB * KVLEN * KVP * 2 <= WS_Y && WS_HID + (size_t)NSLOT_ALL * D * 2 <= WS_Y, "ws map 2");

constexpr int CW_BAR = 4096;

constexpr int RING_BYTES = 131072;
constexpr int LDSCTL_OFF = RING_BYTES, MISC_OFF = LDSCTL_OFF + 320;
constexpr int GTAB_OFF = RING_BYTES + 1024;
constexpr int LDS_BYTES = 147456;
static_assert(GTAB_OFF + 9 * 256 * 4 <= LDS_BYTES, "lds map");

#define LDS_WAIT() asm volatile("s_waitcnt lgkmcnt(0)" ::: "memory")
#define VM_WAIT() asm volatile("s_waitcnt vmcnt(0)" ::: "memory")
__device__ __forceinline__ unsigned f2bf(float f) { unsigned u = __builtin_bit_cast(unsigned, f); return (u + 0x7fffu + ((u >> 16) & 1u)) >> 16; }
__device__ __forceinline__ unsigned cvt_pk_bf16(float lo, float hi) { unsigned r; asm volatile("v_cvt_pk_bf16_f32 %0, %1, %2" : "=v"(r) : "v"(lo), "v"(hi)); return r; }
__device__ __forceinline__ unsigned pk2(float lo, float hi) { unsigned r; asm("v_cvt_pk_bf16_f32 %0, %1, %2" : "=v"(r) : "v"(lo), "v"(hi)); return r; }
__device__ __forceinline__ float bf_lo(unsigned w) { return __builtin_bit_cast(float, w << 16); }
__device__ __forceinline__ float bf_hi(unsigned w) { return __builtin_bit_cast(float, w & 0xffff0000u); }
__device__ __forceinline__ float wave_sum(float v) {
#pragma unroll
    for (int o = 1; o < 64; o <<= 1) v += __shfl_xor(v, o);
    return v;
}

#define XB_TMO      128
#define XB_XCNT(j)  (256  + 64 * (j))
#define XB_XSUB(j)  (1280 + 64 * (j))
#define XB_XGEN(j)  (2304 + 64 * (j))
#define XB_TOP      3328
#define XB_TOPGEN   3392
#define XCD_BAR_WORDS 3456
#define XB_SPIN_CAP (1u << 18)

__device__ __forceinline__ unsigned xb_ld(unsigned* p)              { return __hip_atomic_load(p, __ATOMIC_RELAXED, __HIP_MEMORY_SCOPE_AGENT); }
__device__ __forceinline__ unsigned xb_add(unsigned* p, unsigned v) { return __hip_atomic_fetch_add(p, v, __ATOMIC_RELAXED, __HIP_MEMORY_SCOPE_AGENT); }
__device__ __forceinline__ unsigned xb_xcc_id() { return (unsigned)__builtin_amdgcn_s_getreg((3 << 11) | 20) & 0xFu; }
#define XB_SPIN(cond, bar) do { unsigned _sp = 0; while (cond) { __builtin_amdgcn_s_sleep(1); \
    if ((++_sp & 255u) == 0u) { if (xb_ld(&(bar)[XB_TMO])) break; if (_sp > XB_SPIN_CAP) { atomicAdd(&(bar)[XB_TMO], 1u); break; } } } } while (0)

struct XcdBarrier { unsigned* bar; unsigned x; volatile LAS unsigned* st; };

__device__ __forceinline__ XcdBarrier xcd_barrier_post(unsigned* bar, volatile LAS unsigned* st) {
    XcdBarrier b; b.bar = bar; b.x = xb_xcc_id(); b.st = st;
    if (threadIdx.x == 0) (void)xb_add(&bar[XB_XCNT(b.x)], 1u);
    return b;
}
__device__ __forceinline__ void xcd_barrier_complete(unsigned* bar, unsigned x, unsigned& nloc, unsigned& nx) {
    const unsigned G = gridDim.x * gridDim.y * gridDim.z;
    unsigned sum, cnt, mine, sp = 0u;
    for (;;) {
        sum = 0u; cnt = 0u; mine = 0u;
#pragma unroll
        for (unsigned j = 0; j < 16; ++j) { const unsigned c = xb_ld(&bar[XB_XCNT(j)]); sum += c; cnt += (c > 0u) ? 1u : 0u; mine = (j == x) ? c : mine; }
        if (sum == G) break;
        __builtin_amdgcn_s_sleep(1);
        if ((++sp & 255u) == 0u) { if (xb_ld(&bar[XB_TMO])) break; if (sp > XB_SPIN_CAP) { atomicAdd(&bar[XB_TMO], 1u); break; } }
    }
    nloc = mine > 0u ? mine : 1u; nx = cnt > 0u ? cnt : 1u;
}
__device__ __forceinline__ void xcd_barrier(const XcdBarrier& b) {
    asm volatile("s_waitcnt vmcnt(0)" ::: "memory");
    __syncthreads();
    if (threadIdx.x == 0) {
        unsigned* bar = b.bar;
        __builtin_amdgcn_s_waitcnt(0);
        unsigned nloc = b.st[0], nx = b.st[1];
        if (nloc == 0u) { xcd_barrier_complete(bar, b.x, nloc, nx); b.st[0] = nloc; b.st[1] = nx; }
        const unsigned old = xb_add(&bar[XB_XSUB(b.x)], 1u);
        const unsigned gen = old / nloc;
        if (old + 1u == (gen + 1u) * nloc) {
            __builtin_amdgcn_fence(__ATOMIC_RELEASE, "agent");
            asm volatile("s_waitcnt vmcnt(0)" ::: "memory");
            const unsigned og = xb_add(&bar[XB_TOP], 1u);
            const unsigned tg = og / nx;
            if (og + 1u == (tg + 1u) * nx) xb_add(&bar[XB_TOPGEN], 1u);
            else XB_SPIN(xb_ld(&bar[XB_TOPGEN]) == tg, bar);
            __builtin_amdgcn_fence(__ATOMIC_ACQUIRE, "agent");
            xb_add(&bar[XB_XGEN(b.x)], 1u);
            asm volatile("s_waitcnt vmcnt(0)" ::: "memory");
        } else {
            XB_SPIN(xb_ld(&bar[XB_XGEN(b.x)]) == gen, bar);
            __builtin_amdgcn_fence(__ATOMIC_ACQUIRE, "agent");
            asm volatile("s_waitcnt vmcnt(0)" ::: "memory");
        }
    }
    __syncthreads();
}

namespace pg8 {
typedef int v8i32 __attribute__((ext_vector_type(8)));
typedef int i32x4 __attribute__((ext_vector_type(4)));
constexpr int BM = 256, BK = 64, HALF = 128, HTB = HALF * BK * 2, STAGE_BYTES = 8 * HTB, NXCD = 8, WGM = 8;
constexpr int KD = 1024;
__host__ __device__ __forceinline__ int lds_byte(int r, int c) { const int st = (r >> 4) * 2 + (c >> 5), rr = r & 15, cc = c & 31, ob = rr * 64 + cc * 2; return st * 1024 + (ob ^ (((ob >> 9) & 1) << 5)); }
__host__ __device__ __forceinline__ void stage_rc(int b, int& R, int& C) { const int st = b / 1024, sb = b % 1024, swz = sb ^ (((sb >> 9) & 1) << 5); R = (st >> 1) * 16 + swz / 64; C = (st & 1) * 32 + (swz % 64) / 2; }

struct Unit { int pm, pn; };
constexpr float SC_W = 256.f, SC_H2 = 8.f, SC_HID = 4.f, SC_Y = 64.f, SC_O = 64.f;
__device__ __forceinline__ float clamp448(float x) { return __builtin_fminf(__builtin_fmaxf(x, -448.f), 448.f); }
__device__ __forceinline__ unsigned pack4_fp8(float a, float b, float c, float d) {
    int p = __builtin_amdgcn_cvt_pk_fp8_f32(clamp448(a), clamp448(b), 0, false); p = __builtin_amdgcn_cvt_pk_fp8_f32(clamp448(c), clamp448(d), p, true); return (unsigned)p; }

struct StaticOrder {
    int nM, nN, nwg, G, c;
    __device__ __forceinline__ void init(int nM_, int nN_, int G_, int c_) { nM = nM_; nN = nN_; nwg = nM * nN; G = G_; c = c_; }
    __device__ __forceinline__ bool next(int i, Unit& u) const {
        const long L = (long)i * G + c; if (L >= nwg) return false;
        int wgid = (int)L; { const int q = nwg / NXCD, r = nwg % NXCD, xcd = wgid % NXCD, off = wgid / NXCD; wgid = (xcd < r ? xcd * (q + 1) : r * (q + 1) + (xcd - r) * q) + off; }
        const int nig = WGM * nN, gid = wgid / nig, fm = gid * WGM, gsz = (nM - fm) < WGM ? (nM - fm) : WGM;
        u.pm = fm + ((wgid % nig) % gsz); u.pn = (wgid % nig) / gsz; return true;
    }
};
struct UpOrder {
    int G, c, nunits;
    __device__ __forceinline__ void init(int G_, int c_, bool with_ctx) { G = G_; c = c_; nunits = with_ctx ? 2304 : 2048; }
    __device__ __forceinline__ bool next(int i, Unit& u) const {
        const int L = i * G + c; if (L >= nunits) return false;
        const int rnd = L >> 8, v = L & 255, x = v & 7, j = v >> 3;
        if (rnd < 8) { const int e = 2 * x + (rnd >> 2), b = 4 * (rnd & 3) + (j >> 3); u.pm = e * 16 + b; u.pn = e * 8 + (j & 7); }
        else { const int t = 4 * x + (j >> 3); u.pm = 256 + t; u.pn = (t >> 1) * 8 + (j & 7); }
        return true;
    }
};
struct DnOrder {
    int G, c, nunits;
    __device__ __forceinline__ void init(int G_, int c_, bool with_ctx) { G = G_; c = c_; nunits = with_ctx ? 1152 : 1024; }
    __device__ __forceinline__ bool next(int i, Unit& u) const {
        const int L = i * G + c; if (L >= nunits) return false;
        const int rnd = L >> 8, v = L & 255;
        if (rnd < 4) { const int x = v & 7, j = v >> 3, e = 2 * x + (rnd >> 1), b = 8 * (rnd & 1) + (j >> 2); u.pm = e * 16 + b; u.pn = e * 4 + (j & 3); }
        else { const int x = v & 7, j = v >> 3  , t = 4 * x + (j >> 2); u.pm = 256 + t; u.pn = (t >> 1) * 4 + (j & 3); }
        return true;
    }
};

template <class Epi, class Sched, bool GATHER, bool ALIGN_EPI, bool SP2, bool FP8 = false>
__device__ __forceinline__ void gemm_phase(LAS unsigned char* lds, const bf16_t* A, const bf16_t* Bt, const LAS unsigned* gtab, const Sched& S, const Epi& E, const int krot = 0) {
    int tid_ = threadIdx.x; asm volatile("" : "+v"(tid_));
    const int tid = tid_, wid = __builtin_amdgcn_readfirstlane(tid >> 6), lane = tid & 63, wr = wid >> 2, wc = wid & 3, fr = lane & 15, fq = lane >> 4;
    constexpr int ROWB = FP8 ? KD : 2 * KD  , nt = ROWB / 128;
    unsigned voffA[2], voffB[2]; int RA[2];
#pragma unroll
    for (int i = 0; i < 2; ++i) { int R, C; stage_rc(tid * 16 + i * 8192, R, C); RA[i] = R;
        voffA[i] = GATHER ? (unsigned)(C * 2) : (unsigned)(R * ROWB + C * 2); voffB[i] = (unsigned)(R * ROWB + C * 2); }
    constexpr size_t kstep = (size_t)(BK * 2);
#define PG8_KO(t) ((size_t)((((t) + krot) & (nt - 1))) * kstep)
    constexpr size_t hstep = (size_t)HALF * ROWB;
    constexpr size_t tstep = 2 * hstep;
    const unsigned ldsw = (unsigned)wid * 1024u;
    const int aoff = lds_byte(wr * 64 + fr, fq * 8), boff = lds_byte(wc * 32 + fr, fq * 8);
#define PG8_SA(b, h) (((b) * 2 + (h)) * HTB)
#define PG8_SB(b, h) ((4 + (b) * 2 + (h)) * HTB)
#define PG8_STAGE(bufoff, gbase, voff) do { const char* gb_ = (const char*)(gbase); asm volatile("" : "+s"(gb_));     \
        _Pragma("unroll") for (int _i = 0; _i < 2; ++_i) \
        __builtin_amdgcn_global_load_lds((const unsigned*)(gb_ + (voff)[_i]), (LAS unsigned*)(lds + (bufoff) + ldsw + _i * 8192), 16, 0, 0); } while (0)
#define PG8_STAGE_A(bufoff, gbase, h, vo) do { if constexpr (GATHER) { PG8_STAGE(bufoff, gbase, (vo)[h]); } else { PG8_STAGE(bufoff, (gbase) + (h) * hstep, voffA); } } while (0)
#define PG8_LDA(dst, b, h) do { _Pragma("unroll") for (int m = 0; m < 4; ++m) _Pragma("unroll") for (int k = 0; k < 2; ++k) dst[m][k] = *(const LAS bf16x8*)(lds + PG8_SA(b, h) + aoff + m * 2048 + k * 1024); } while (0)
#define PG8_LDB(dst, b, h) do { _Pragma("unroll") for (int n = 0; n < 2; ++n) _Pragma("unroll") for (int k = 0; k < 2; ++k) dst[n][k] = *(const LAS bf16x8*)(lds + PG8_SB(b, h) + boff + n * 2048 + k * 1024); } while (0)
#define PG8_MMA(ai, bj, At, Bt_, Z) do { __builtin_amdgcn_s_setprio(1); _Pragma("unroll") for (int m = 0; m < 4; ++m) _Pragma("unroll") for (int n = 0; n < 2; ++n) { \
        if constexpr (FP8) { const v8i32 a8 = __builtin_shufflevector(__builtin_bit_cast(i32x4, At[m][0]), __builtin_bit_cast(i32x4, At[m][1]), 0, 1, 2, 3, 4, 5, 6, 7); \
            const v8i32 b8 = __builtin_shufflevector(__builtin_bit_cast(i32x4, Bt_[n][0]), __builtin_bit_cast(i32x4, Bt_[n][1]), 0, 1, 2, 3, 4, 5, 6, 7); \
            if constexpr (Z) asm volatile("v_mfma_f32_16x16x128_f8f6f4 %0, %1, %2, 0" : "=&v"(acc[ai][bj][m][n]) : "v"(b8), "v"(a8));     \
            else asm volatile("v_mfma_f32_16x16x128_f8f6f4 %0, %1, %2, %0" : "+v"(acc[ai][bj][m][n]) : "v"(b8), "v"(a8)); }     \
        else { if constexpr (Z) { acc[ai][bj][m][n] = __builtin_amdgcn_mfma_f32_16x16x32_bf16(Bt_[n][0], At[m][0], (f32x4){0.f, 0.f, 0.f, 0.f}, 0, 0, 0); acc[ai][bj][m][n] = __builtin_amdgcn_mfma_f32_16x16x32_bf16(Bt_[n][1], At[m][1], acc[ai][bj][m][n], 0, 0, 0); } \
            else { _Pragma("unroll") for (int k = 0; k < 2; ++k) acc[ai][bj][m][n] = __builtin_amdgcn_mfma_f32_16x16x32_bf16(Bt_[n][k], At[m][k], acc[ai][bj][m][n], 0, 0, 0); } } } \
        __builtin_amdgcn_s_setprio(0); } while (0)
#define PG8_WAIT_V(n) asm volatile("s_waitcnt vmcnt(" #n ")" ::: "memory")
#define PG8_WAIT_L(n) asm volatile("s_waitcnt lgkmcnt(" #n ")" ::: "memory")
#define PG8_BAR __builtin_amdgcn_s_barrier()
#define PG8_SCHED __builtin_amdgcn_sched_barrier(0)
#define PG8_GLOAD(vo, ui_) do { if constexpr (GATHER) { _Pragma("unroll") for (int _h = 0; _h < 2; ++_h) _Pragma("unroll") for (int _i = 0; _i < 2; ++_i) (vo)[_h][_i] = gtab[(ui_) * 256 + _h * 128 + RA[_i]] + voffA[_i]; } } while (0)
    Unit cur, nxt; int ui = 0;
    if (!S.next(0, cur)) return;
    int sc1 = 0x7f7f7f7f; asm volatile("" : "+v"(sc1));
    f32x4 acc[2][2][4][2];
    bf16x8 At[4][2], B0[2][2], B1[2][2];
    unsigned cvo[2][2], nvo[2][2];
    PG8_GLOAD(cvo, 0);
#pragma unroll
    for (int _h = 0; _h < 2; ++_h)
#pragma unroll
        for (int _i = 0; _i < 2; ++_i) nvo[_h][_i] = GATHER ? cvo[_h][_i] : 0u;
    const char* cA = GATHER ? (const char*)A : (const char*)A + (size_t)cur.pm * tstep; const char* cB = (const char*)Bt + (size_t)cur.pn * tstep;
    if constexpr (GATHER) { LDS_WAIT(); }
    if constexpr (SP2) {
        PG8_STAGE(PG8_SB(0, 0), cB + PG8_KO(0), voffB); PG8_STAGE(PG8_SB(0, 1), cB + hstep + PG8_KO(0), voffB); PG8_STAGE_A(PG8_SA(0, 0), cA + PG8_KO(0), 0, cvo); PG8_STAGE_A(PG8_SA(0, 1), cA + PG8_KO(0), 1, cvo);
        if (wr == 1) PG8_BAR;
        PG8_WAIT_V(2); PG8_BAR;
        PG8_STAGE(PG8_SB(1, 0), cB + PG8_KO(1), voffB); PG8_STAGE_A(PG8_SA(1, 0), cA + PG8_KO(1), 0, cvo); PG8_STAGE(PG8_SB(1, 1), cB + hstep + PG8_KO(1), voffB);
        PG8_WAIT_V(6); PG8_BAR;
    } else {
        PG8_STAGE(PG8_SB(0, 0), cB + PG8_KO(0), voffB); PG8_STAGE_A(PG8_SA(0, 0), cA + PG8_KO(0), 0, cvo); PG8_STAGE(PG8_SB(0, 1), cB + hstep + PG8_KO(0), voffB); PG8_STAGE_A(PG8_SA(0, 1), cA + PG8_KO(0), 1, cvo);
        if (wr == 1) PG8_BAR;
        PG8_WAIT_V(4); PG8_BAR;
        PG8_STAGE(PG8_SB(1, 0), cB + PG8_KO(1), voffB); PG8_STAGE_A(PG8_SA(1, 0), cA + PG8_KO(1), 0, cvo); PG8_STAGE(PG8_SB(1, 1), cB + hstep + PG8_KO(1), voffB);
        PG8_WAIT_V(6); PG8_BAR;
    }
    for (;;) {
        const bool has_next = S.next(ui + 1, nxt);
        const char* nA = GATHER ? (const char*)A : (has_next ? (const char*)A + (size_t)nxt.pm * tstep : cA); const char* nB = has_next ? (const char*)Bt + (size_t)nxt.pn * tstep : cB;
        if constexpr (GATHER) { if (has_next) { PG8_GLOAD(nvo, ui + 1); } }
#define PG8_TRIP(t, Z) do { \
            const bool last = (t == nt - 2); \
            const char* a1 = cA + PG8_KO(t + 1); \
            const char* a2 = (last ? nA : cA) + PG8_KO(t + 2); const char* b2 = (last ? nB : cB) + PG8_KO(t + 2);     \
            const char* a3 = a2 + kstep; const char* b3 = b2 + kstep; \
            unsigned xvo[2][2];     \
_Pragma("unroll") \
            for (int _h = 0; _h < 2; ++_h) \
_Pragma("unroll") \
                for (int _i = 0; _i < 2; ++_i) xvo[_h][_i] = GATHER ? (last ? nvo[_h][_i] : cvo[_h][_i]) : 0u; \
            if constexpr (SP2) { \
            PG8_LDB(B0, 0, 0); PG8_LDB(B1, 0, 1); PG8_SCHED; PG8_LDA(At, 0, 0); PG8_STAGE_A(PG8_SA(1, 1), a1, 1, cvo); \
            PG8_WAIT_V(8); PG8_WAIT_L(0); PG8_BAR; PG8_MMA(0, 0, At, B0, Z); PG8_MMA(0, 1, At, B1, Z); PG8_BAR; PG8_SCHED; \
            PG8_LDA(At, 0, 1); PG8_STAGE(PG8_SB(0, 0), b2, voffB); PG8_STAGE(PG8_SB(0, 1), b2 + hstep, voffB); PG8_STAGE_A(PG8_SA(0, 0), a2, 0, xvo); \
            PG8_WAIT_V(8); PG8_WAIT_L(0); PG8_BAR; PG8_MMA(1, 0, At, B0, Z); PG8_MMA(1, 1, At, B1, Z); PG8_BAR; PG8_SCHED; \
            PG8_LDB(B0, 1, 0); PG8_LDB(B1, 1, 1); PG8_SCHED; PG8_LDA(At, 1, 0); PG8_STAGE_A(PG8_SA(0, 1), a2, 1, xvo); \
            PG8_WAIT_V(8); PG8_WAIT_L(0); PG8_BAR; PG8_MMA(0, 0, At, B0, false); PG8_MMA(0, 1, At, B1, false); PG8_BAR; PG8_SCHED; \
            PG8_LDA(At, 1, 1); PG8_STAGE(PG8_SB(1, 0), b3, voffB); PG8_STAGE(PG8_SB(1, 1), b3 + hstep, voffB); PG8_STAGE_A(PG8_SA(1, 0), a3, 0, xvo); \
            PG8_WAIT_V(8); PG8_WAIT_L(0); PG8_BAR; PG8_MMA(1, 0, At, B0, false); PG8_MMA(1, 1, At, B1, false); PG8_BAR; PG8_SCHED; \
            } else { \
            PG8_LDB(B0, 0, 0); PG8_SCHED; PG8_LDA(At, 0, 0); PG8_STAGE_A(PG8_SA(1, 1), a1, 1, cvo); \
            PG8_WAIT_L(8); PG8_BAR; PG8_WAIT_L(0); PG8_MMA(0, 0, At, B0, Z); PG8_BAR; PG8_SCHED; \
            PG8_LDB(B1, 0, 1); PG8_STAGE(PG8_SB(0, 0), b2, voffB); \
            PG8_BAR; PG8_WAIT_L(0); PG8_MMA(0, 1, At, B1, Z); PG8_BAR; \
            PG8_LDA(At, 0, 1); PG8_STAGE_A(PG8_SA(0, 0), a2, 0, xvo); \
            PG8_BAR; PG8_WAIT_L(0); PG8_MMA(1, 0, At, B0, Z); PG8_BAR; PG8_SCHED; \
            PG8_STAGE(PG8_SB(0, 1), b2 + hstep, voffB); \
            PG8_WAIT_V(6); PG8_BAR; PG8_MMA(1, 1, At, B1, Z); PG8_BAR; \
            PG8_LDB(B0, 1, 0); PG8_SCHED; PG8_LDA(At, 1, 0); PG8_STAGE_A(PG8_SA(0, 1), a2, 1, xvo); \
            PG8_WAIT_L(8); PG8_BAR; PG8_WAIT_L(0); PG8_MMA(0, 0, At, B0, false); PG8_BAR; PG8_SCHED; \
            PG8_LDB(B1, 1, 1); PG8_STAGE(PG8_SB(1, 0), b3, voffB); \
            PG8_BAR; PG8_WAIT_L(0); PG8_MMA(0, 1, At, B1, false); PG8_BAR; \
            PG8_LDA(At, 1, 1); PG8_STAGE_A(PG8_SA(1, 0), a3, 0, xvo); \
            PG8_BAR; PG8_WAIT_L(0); PG8_MMA(1, 0, At, B0, false); PG8_BAR; PG8_SCHED; \
            PG8_STAGE(PG8_SB(1, 1), b3 + hstep, voffB); \
            PG8_WAIT_V(6); PG8_BAR; PG8_MMA(1, 1, At, B1, false); PG8_BAR; \
            } \
        } while (0)
        PG8_TRIP(0, true);
#pragma unroll 1
        for (int t = 2; t < nt; t += 2) PG8_TRIP(t, false);
#undef PG8_TRIP
        if constexpr (ALIGN_EPI) { if (wr == 0) PG8_BAR; }
        if constexpr (FP8) { asm volatile("s_nop 15\n\ts_nop 15\n\ts_nop 15\n\ts_nop 15" ::: "memory"); }
        E(acc, cur, wr, wc, fr, fq);
        if (!has_next) break;
        cur = nxt; cA = nA; cB = nB; ++ui;
#pragma unroll
        for (int _h = 0; _h < 2; ++_h)
#pragma unroll
            for (int _i = 0; _i < 2; ++_i) cvo[_h][_i] = nvo[_h][_i];
        if constexpr (ALIGN_EPI) { if (wr == 1) PG8_BAR; }
    }
    PG8_WAIT_V(0);
    if constexpr (!ALIGN_EPI) { if (wr == 0) PG8_BAR; }
    PG8_BAR;
#undef PG8_SA
#undef PG8_SB
#undef PG8_STAGE
#undef PG8_STAGE_A
#undef PG8_LDA
#undef PG8_LDB
#undef PG8_MMA
#undef PG8_WAIT_V
#undef PG8_WAIT_L
#undef PG8_BAR
#undef PG8_SCHED
#undef PG8_GLOAD
#undef PG8_KO
}


__device__ __forceinline__ int kv_row(int r) { return r < NLAT ? (r >> 11) * KVLEN + (r & 2047) : ((r - NLAT) >> 8) * KVLEN + SEQ + ((r - NLAT) & 255); }

struct EpiAttnIn {
    bf16_t* Q; bf16_t* Kb; bf16_t* Vb; const float* gam4; const f32x2* rope;
    __device__ __forceinline__ void operator()(const f32x4 (&acc)[2][2][4][2], const Unit& u, int wr, int wc, int fr, int fq) const {
        const int pn = u.pn, grp = pn >= 3 ? 1 : 0, pl = pn - 3 * grp;
        const bool isq = pl < 2, isv = (pl == 2) && (wc >= 2), lat = u.pm < (NLAT / 256);
        const float* gam = gam4 + (grp * 2 + (isq ? 0 : 1)) * 64;
        f32x4 gv[2][2];
#pragma unroll
        for (int bj = 0; bj < 2; ++bj)
#pragma unroll
            for (int n = 0; n < 2; ++n) gv[bj][n] = *(const f32x4*)(gam + 32 * bj + 16 * n + 4 * fq);
        const float qs = isq ? C2 : 1.f;
        f32x4 c0v[2][2], c1v[4][2];
        if (lat && !isv) {
#pragma unroll
            for (int ai = 0; ai < 2; ++ai) { const GAS f32x4* p = (const GAS f32x4*)(rope + (((u.pm & 7) * 4 + ai * 2 + wr) * 16 + 4 * fq)); c0v[ai][0] = p[0]; c0v[ai][1] = p[1]; }
#pragma unroll
            for (int m = 0; m < 4; ++m) { const GAS f32x4* p = (const GAS f32x4*)(rope + ((m * 16 + fr) * 16 + 4 * fq)); c1v[m][0] = p[0]; c1v[m][1] = p[1]; }
        }
#pragma unroll
        for (int ai = 0; ai < 2; ++ai)
#pragma unroll
            for (int m = 0; m < 4; ++m) {
                const int r = u.pm * BM + ai * HALF + wr * 64 + m * 16 + fr;
                f32x4 v[2][2];
                constexpr float ds = 1.0f / (SC_W * SC_H2);
                constexpr float EPSA = EPS / (ds * ds);
                if (ai == 0 && m == 0) __builtin_amdgcn_s_waitcnt(0x0F70);
                if (!isv) {
                    float ss = 0.f;
#pragma unroll
                    for (int bj = 0; bj < 2; ++bj)
#pragma unroll
                        for (int n = 0; n < 2; ++n) { const f32x4 a = acc[ai][bj][m][n]; ss += (a[0] * a[0] + a[1] * a[1]) + (a[2] * a[2] + a[3] * a[3]); }
                    ss += __shfl_xor(ss, 16); ss += __shfl_xor(ss, 32);
                    const float rs = __builtin_amdgcn_rsqf(ss * (1.0f / 64.0f) + EPSA) * qs;
#pragma unroll
                    for (int bj = 0; bj < 2; ++bj)
#pragma unroll
                        for (int n = 0; n < 2; ++n) v[bj][n] = acc[ai][bj][m][n] * (gv[bj][n] * rs);
                    if (lat) {
#pragma unroll
                        for (int bj = 0; bj < 2; ++bj) {
#pragma unroll
                            for (int e = 0; e < 4; ++e) { const f32x4 cv = bj ? c1v[m][e >> 1] : c0v[ai][e >> 1]; const float cx = cv[2 * (e & 1)], cy = cv[2 * (e & 1) + 1]; const float a = v[bj][0][e], b = v[bj][1][e];
                                v[bj][0][e] = a * cx - b * cy; v[bj][1][e] = a * cy + b * cx; }
                        }
                    }
                } else {
#pragma unroll
                    for (int bj = 0; bj < 2; ++bj)
#pragma unroll
                        for (int n = 0; n < 2; ++n) v[bj][n] = acc[ai][bj][m][n] * ds;
                }
                bf16_t* dst;
                if (isq) dst = Q + (size_t)r * D + (grp * 8 + pl * 4 + wc) * HD;
                else if (!isv) dst = Kb + (size_t)kv_row(r) * KVP + (grp * 2 + wc) * HD;
                else dst = Vb + (size_t)kv_row(r) * KVP + (grp * 2 + wc - 2) * HD;
#pragma unroll
                for (int bj = 0; bj < 2; ++bj)
#pragma unroll
                    for (int n = 0; n < 2; ++n) { u32x2 w; w.x = cvt_pk_bf16(v[bj][n][0], v[bj][n][1]); w.y = cvt_pk_bf16(v[bj][n][2], v[bj][n][3]);
                        *(u32x2*)(dst + 32 * bj + 16 * n + 4 * fq) = w; }
            }
    }
};

#ifndef RESID_XPF
#define RESID_XPF 6
#endif
struct EpiResid {
    bf16_t* X; const float* modL; int goff; float ds;
    __device__ __forceinline__ void operator()(const f32x4 (&acc)[2][2][4][2], const Unit& u, int wr, int wc, int fr, int fq) const {
        const int b = u.pm < (NLAT / 256) ? (u.pm >> 3) : 16;
        const float* g = modL + b * 6144 + goff;
        const int row0 = u.pm * BM + wr * 64 + fr, col0 = u.pn * BM + wc * 32 + 8 * fq;
        f32x4 gv[2][2];
#pragma unroll
        for (int bj = 0; bj < 2; ++bj)
#pragma unroll
            for (int n = 0; n < 2; ++n) gv[bj][n] = *(const f32x4*)(g + col0 + bj * HALF + 4 * n) * ds;
        constexpr int XPF = RESID_XPF;
        u32x4 xv[8][2];
#define RESID_LD(j) do { _Pragma("unroll") for (int bj = 0; bj < 2; ++bj) xv[j][bj] = *(const GAS u32x4*)(X + (size_t)(row0 + ((j) >> 2) * HALF + ((j) & 3) * 16) * D + col0 + bj * HALF); } while (0)
#pragma unroll
        for (int j = 0; j < XPF; ++j) RESID_LD(j);
#pragma unroll
        for (int j = 0; j < 8; ++j) { const int ai = j >> 2, m = j & 3; bf16_t* rowp = X + (size_t)(row0 + ai * HALF + m * 16) * D + col0;
            if (j + XPF < 8) RESID_LD(j + XPF);
            asm volatile("" ::: "memory");
#pragma unroll
            for (int bj = 0; bj < 2; ++bj) { const u32x4 x = xv[j][bj];
                const f32x4 x0 = (f32x4){bf_lo(x.x), bf_hi(x.x), bf_lo(x.y), bf_hi(x.y)}, x1 = (f32x4){bf_lo(x.z), bf_hi(x.z), bf_lo(x.w), bf_hi(x.w)};
                const f32x4 r0 = acc[ai][bj][m][0] * gv[bj][0] + x0, r1 = acc[ai][bj][m][1] * gv[bj][1] + x1;
                u32x4 w; w.x = cvt_pk_bf16(r0[0], r0[1]); w.y = cvt_pk_bf16(r0[2], r0[3]); w.z = cvt_pk_bf16(r1[0], r1[1]); w.w = cvt_pk_bf16(r1[2], r1[3]);
                *(GAS u32x4*)(rowp + bj * HALF) = w; } }
#undef RESID_LD
    }
};

struct EpiConvIn {
    bf16_t* BG; bf16_t* U;
    __device__ __forceinline__ void operator()(const f32x4 (&acc)[2][2][4][2], const Unit& u, int wr, int wc, int fr, int fq) const {
        const int row0 = u.pm * BM + wr * 64 + fr;
        if (u.pn < 4) {
            const int col0 = u.pn * BM + wc * 32 + 8 * fq;
#pragma unroll
            for (int ai = 0; ai < 2; ++ai)
#pragma unroll
                for (int m = 0; m < 4; ++m) { bf16_t* rowp = BG + (size_t)(row0 + ai * HALF + m * 16) * D + col0;
#pragma unroll
                    for (int bj = 0; bj < 2; ++bj) { const f32x4 v0 = acc[ai][bj][m][0], v1 = acc[ai][bj][m][1]; u32x4 w;
                        w.x = cvt_pk_bf16(v0[0], v0[1]); w.y = cvt_pk_bf16(v0[2], v0[3]); w.z = cvt_pk_bf16(v1[0], v1[1]); w.w = cvt_pk_bf16(v1[2], v1[3]);
                        *(u32x4*)(rowp + bj * HALF) = w; } }
        } else {
            const int col0 = (u.pn - 4) * 128 + wc * 32 + 8 * fq;
#pragma unroll
            for (int ai = 0; ai < 2; ++ai)
#pragma unroll
                for (int m = 0; m < 4; ++m) { bf16_t* rowp = U + (size_t)(row0 + ai * HALF + m * 16) * D + col0;
                    const f32x4 v0 = acc[ai][0][m][0] * acc[ai][1][m][0], v1 = acc[ai][0][m][1] * acc[ai][1][m][1]; u32x4 w;
                    w.x = cvt_pk_bf16(v0[0], v0[1]); w.y = cvt_pk_bf16(v0[2], v0[3]); w.z = cvt_pk_bf16(v1[0], v1[1]); w.w = cvt_pk_bf16(v1[2], v1[3]);
                    *(u32x4*)rowp = w; }
        }
    }
};

__device__ __forceinline__ float silu_f(float g) { return g * __builtin_amdgcn_rcpf(1.0f + __builtin_amdgcn_exp2f(-g * LOG2E)); }
struct EpiUp {
    unsigned char* HID8;
    __device__ __forceinline__ void operator()(const f32x4 (&acc)[2][2][4][2], const Unit& u, int wr, int wc, int fr, int fq) const {
        const int row0 = u.pm * BM + wr * 64 + fr, col0 = (u.pn & 7) * 128 + wc * 32 + 8 * fq;
        constexpr float ds = 1.0f / (SC_W * SC_H2);
        constexpr float c1 = -ds * LOG2E, kk = 1.0f / (ds * ds * SC_HID);
#pragma unroll
        for (int ai = 0; ai < 2; ++ai)
#pragma unroll
            for (int m = 0; m < 4; ++m) { unsigned char* rowp = HID8 + (size_t)(row0 + ai * HALF + m * 16) * D + col0;
                const f32x4 g0 = acc[ai][0][m][0], g1 = acc[ai][0][m][1], u0 = acc[ai][1][m][0], u1 = acc[ai][1][m][1];
                f32x4 t0 = g0 * c1, t1 = g1 * c1;
#pragma unroll
                for (int e = 0; e < 4; ++e) { t0[e] = __builtin_amdgcn_exp2f(t0[e]); t1[e] = __builtin_amdgcn_exp2f(t1[e]); }
                f32x4 d0 = t0 * kk + kk, d1 = t1 * kk + kk;
#pragma unroll
                for (int e = 0; e < 4; ++e) { d0[e] = __builtin_amdgcn_rcpf(d0[e]); d1[e] = __builtin_amdgcn_rcpf(d1[e]); }
                const f32x4 v0 = (g0 * u0) * d0, v1 = (g1 * u1) * d1;
                u32x2 w; w.x = pack4_fp8(v0[0], v0[1], v0[2], v0[3]); w.y = pack4_fp8(v1[0], v1[1], v1[2], v1[3]);
                *(u32x2*)rowp = w; }
    }
};
struct EpiDown {
    unsigned char* Y8; const float* gate; const float* modL;
    __device__ __forceinline__ void operator()(const f32x4 (&acc)[2][2][4][2], const Unit& u, int wr, int wc, int fr, int fq) const {
        const int b = u.pm < 256 ? (u.pm & 15) : 16;
        const float* g2 = modL + b * 6144 + 5 * 1024;
        const int row0 = u.pm * BM + wr * 64 + fr, col0 = (u.pn & 3) * BM + wc * 32 + 8 * fq;
        constexpr float ds = SC_Y / (SC_W * SC_HID);
        f32x4 gv[2][2];
#pragma unroll
        for (int bj = 0; bj < 2; ++bj)
#pragma unroll
            for (int n = 0; n < 2; ++n) gv[bj][n] = *(const f32x4*)(g2 + col0 + bj * HALF + 4 * n) * ds;
        float gts[2][4];
#pragma unroll
        for (int ai = 0; ai < 2; ++ai)
#pragma unroll
            for (int m = 0; m < 4; ++m) gts[ai][m] = ((const GAS float*)gate)[row0 + ai * HALF + m * 16];
#pragma unroll
        for (int ai = 0; ai < 2; ++ai)
#pragma unroll
            for (int m = 0; m < 4; ++m) { const int row = row0 + ai * HALF + m * 16; const float gt = gts[ai][m]; unsigned char* rowp = Y8 + (size_t)row * D + col0;
#pragma unroll
                for (int bj = 0; bj < 2; ++bj) { const f32x4 v0 = acc[ai][bj][m][0] * (gv[bj][0] * gt), v1 = acc[ai][bj][m][1] * (gv[bj][1] * gt); u32x2 w;
                    w.x = pack4_fp8(v0[0], v0[1], v0[2], v0[3]); w.y = pack4_fp8(v1[0], v1[1], v1[2], v1[3]);
                    *(u32x2*)(rowp + bj * HALF) = w; } }
    }
};
}

struct Frame {
    LAS unsigned char* lds;
    int tid, lane, wave, G;
    float* out; unsigned char* ws;
};
constexpr int PT_OFF = LDSCTL_OFF + 512;
__device__ __forceinline__ const float* inp(const Frame& F, int i) {
    const LAS unsigned* p = (const LAS unsigned*)(F.lds + PT_OFF) + 2 * i;
    const unsigned lo = (unsigned)__builtin_amdgcn_readfirstlane((int)p[0]), hi = (unsigned)__builtin_amdgcn_readfirstlane((int)p[1]);
    return (const float*)(((unsigned long long)hi << 32) | lo);
}
enum { I_X = 0, I_C, I_CTX, I_CCTX, I_ADAW, I_ADAB, I_N1G, I_N2G, I_AWIN, I_AWOUT, I_QNA, I_KNA, I_QNB, I_KNB, I_SINK, I_CWIN, I_CK, I_CB, I_CWOUT, I_RW, I_WG, I_WU, I_WD };

#define PHASE_FRAME(F0) Frame F = F0; { int t_ = threadIdx.x; asm volatile("" : "+v"(t_)); F.tid = t_; F.lane = t_ & 63; F.wave = __builtin_amdgcn_readfirstlane(t_ >> 6); }
__device__ __forceinline__ int inv32(int x) { return 16 * ((x >> 2) & 1) + 4 * (x >> 3) + (x & 3); }
enum { RM_NAT = 0, RM_AIN, RM_P8, RM_CIN, RM_UPG, RM_UPU };
__device__ __forceinline__ int row_map(int mode, int l0, int x) {
    switch (mode) {
    case RM_NAT: return l0 + x;
    case RM_AIN: return (l0 & ~255) + ((l0 >> 5) & 1) * 128 + ((l0 >> 6) & 3) * 32 + x;
    case RM_P8:  return l0 + inv32(x);
    case RM_CIN: if (l0 < 1024) return l0 + inv32(x);
                 else { const int j = (l0 - 1024) & 1023, isv = (l0 >= 2048); return 1024 + 256 * (j >> 7) + 128 * isv + 32 * ((j >> 5) & 3) + inv32(x); }
    case RM_UPG: return 256 * (l0 >> 7) + 32 * ((l0 >> 5) & 3) + inv32(x);
    default:     return 256 * (l0 >> 7) + 128 + 32 * ((l0 >> 5) & 3) + inv32(x);
    }
}
struct TItem { const float* W; bf16_t* WT; int N, mode, item; bool f8; };
__device__ __forceinline__ void titem_load(const TItem& T, int lane, f32x4 (&v)[8]) {
    const int nblk = T.N / 32, kb = T.item / nblk, nb = T.item % nblk, k0 = 64 * kb, n0 = 32 * nb;
#pragma unroll
    for (int i = 0; i < 8; ++i) v[i] = *(const GAS f32x4*)(T.W + (size_t)(k0 + 8 * i + (lane >> 3)) * T.N + n0 + 4 * (lane & 7));
}
__device__ __forceinline__ void titem_store(const TItem& T, int lane, const f32x4 (&v)[8], LAS float* scr) {
    const int nblk = T.N / 32, kb = T.item / nblk, nb = T.item % nblk, k0 = 64 * kb, n0 = 32 * nb;
#pragma unroll
    for (int i = 0; i < 8; ++i) { LAS float* s = scr + (8 * i + (lane >> 3)) * 33 + 4 * (lane & 7); s[0] = v[i][0]; s[1] = v[i][1]; s[2] = v[i][2]; s[3] = v[i][3]; }
    LDS_WAIT(); asm volatile("" ::: "memory");
    const int c = lane & 7;
#pragma unroll
    for (int j = 0; j < 4; ++j) { const int n = (lane >> 3) + 8 * j; const LAS float* s = scr + (8 * c) * 33 + n;
        if (T.f8) { u32x2 o; o.x = pg8::pack4_fp8(s[0 * 33] * pg8::SC_W, s[1 * 33] * pg8::SC_W, s[2 * 33] * pg8::SC_W, s[3 * 33] * pg8::SC_W); o.y = pg8::pack4_fp8(s[4 * 33] * pg8::SC_W, s[5 * 33] * pg8::SC_W, s[6 * 33] * pg8::SC_W, s[7 * 33] * pg8::SC_W);
            *(GAS u32x2*)((unsigned char*)T.WT + (size_t)row_map(T.mode, n0, n) * 1024 + k0 + 8 * c) = o; }
        else { u32x4 o; o.x = pk2(s[0 * 33], s[1 * 33]); o.y = pk2(s[2 * 33], s[3 * 33]); o.z = pk2(s[4 * 33], s[5 * 33]); o.w = pk2(s[6 * 33], s[7 * 33]);
            *(GAS u32x4*)(T.WT + (size_t)row_map(T.mode, n0, n) * 1024 + k0 + 8 * c) = o; } }
    LDS_WAIT(); asm volatile("" ::: "memory");
}
__device__ __forceinline__ void p0_transpose_item(const float* W, int N, bf16_t* WT, int mode, LAS float* scr, int item, int lane, bool f8 = false) {
    const TItem T{W, WT, N, mode, item, f8}; f32x4 v[8]; titem_load(T, lane, v); titem_store(T, lane, v, scr);
}
__device__ __forceinline__ TItem moe_item(Frame& F, int L, int r) {
    constexpr int I_SQ = 16 * (1024 / 32);
    const int mi = r / I_SQ, item = r % I_SQ, e = mi / 3, which = mi % 3;
    const float* W = (which == 0 ? inp(F, I_WG) : which == 1 ? inp(F, I_WU) : inp(F, I_WD)) + (size_t)(L * 16 + e) * 1024 * 1024;
    bf16_t* WT = (bf16_t*)(which < 2 ? F.ws + WS_WUP + (size_t)(L * 16 + e) * 2048 * 1024 : F.ws + WS_WDN + (size_t)(L * 16 + e) * 1024 * 1024);
    return TItem{W, WT, 1024, which == 0 ? RM_UPG : which == 1 ? RM_UPU : RM_P8, item, true};
}
__device__ __forceinline__ void moe_convert_run(Frame& F, int L, int first, int end, int stride, LAS float* scr) {
    if (first >= end) return;
    f32x4 nv[8]; TItem nT = moe_item(F, L, first); titem_load(nT, F.lane, nv);
    for (int r = first; r < end; r += stride) {
        const TItem T = nT; f32x4 v[8];
#pragma unroll
        for (int i = 0; i < 8; ++i) v[i] = nv[i];
        if (r + stride < end) { nT = moe_item(F, L, r + stride); titem_load(nT, F.lane, nv); }
        titem_store(T, F.lane, v, scr);
    }
}
__device__ __forceinline__ void moe_convert_slice(const Frame& F0, int L, int first, int n, int rank, int n_idle) {
    PHASE_FRAME(F0);
    const int per = (n + n_idle - 1) / n_idle, lo = first + rank * per, hi = (lo + per < first + n) ? lo + per : first + n;
    moe_convert_run(F, L, lo + F.wave, hi, 8, (LAS float*)(F.lds + F.wave * 16384));
}
constexpr int CV0_PRO = 12288;
__device__ __forceinline__ void p0_prologue(const Frame& F0) {
    PHASE_FRAME(F0);
    unsigned char* ws = F.ws;
    {
        LAS float* sc = (LAS float*)F.lds;
        LAS float* P = (LAS float*)(F.lds + 17 * 1024 * 4);
        { const GAS float* cp = (const GAS float*)inp(F, I_C) + F.tid; const GAS float* ccp = (const GAS float*)inp(F, I_CCTX) + F.tid;
          float cv[34];
#pragma unroll
          for (int i = 0; i < 32; ++i) cv[i] = cp[512 * i];
          cv[32] = ccp[0]; cv[33] = ccp[512];
#pragma unroll
          for (int i = 0; i < 34; ++i) sc[F.tid + 512 * i] = cv[i] / (1.0f + __expf(-cv[i])); }
        __syncthreads();
        float* mod = (float*)(ws + WS_MOD);
        for (int item = blockIdx.x; item < 256; item += F.G) {
            const int L = item >> 6, n0 = (item & 63) * 96;
            const int kg = F.tid / 24, cq = F.tid % 24;
            f32x4 acc[17];
#pragma unroll
            for (int r = 0; r < 17; ++r) acc[r] = (f32x4){0.f, 0.f, 0.f, 0.f};
            if (kg < 16) {
                const GAS float* wp = (const GAS float*)(inp(F, I_ADAW) + ((size_t)L * 1024 + kg) * 6144 + n0 + 4 * cq);
                f32x4 wa[4], wb[4];
#define MODW_LD(W, j0) do { _Pragma("unroll") for (int q = 0; q < 4; ++q) W[q] = *(const GAS f32x4*)(wp + (size_t)(((j0) + q) & 63) * 16 * 6144); } while (0)
#define MODW_USE(W, j0) do { _Pragma("unroll") for (int q = 0; q < 4; ++q) { const int k = kg + 16 * ((j0) + q); _Pragma("unroll") for (int r = 0; r < 17; ++r) acc[r] += W[q] * sc[r * 1024 + k]; asm volatile("" ::: "memory"); } } while (0)
                MODW_LD(wa, 0);
#pragma unroll 1
                for (int j = 0; j < 64; j += 8) { MODW_LD(wb, j + 4); MODW_USE(wa, j); MODW_LD(wa, j + 8); MODW_USE(wb, j + 4); }
#undef MODW_LD
#undef MODW_USE
            }
#pragma unroll
            for (int batch = 0; batch < 2; ++batch) {
                const int r0 = batch * 9, nr = batch ? 8 : 9;
                if (kg < 16) {
#pragma unroll
                    for (int r = 0; r < 9; ++r) if (r0 + r < 17) *(LAS f32x4*)(P + kg * 864 + r * 96 + 4 * cq) = acc[r0 + r < 17 ? r0 + r : 0];
                }
                __syncthreads();
                for (int o = F.tid; o < nr * 96; o += 512) { float s = 0.f;
#pragma unroll
                    for (int g = 0; g < 16; ++g) s += P[g * 864 + o];
                    const int r = r0 + o / 96, n = n0 + o % 96; mod[((size_t)L * 17 + r) * 6144 + n] = s + inp(F, I_ADAB)[L * 6144 + n]; }
                __syncthreads();
            }
        }
    }
    if (blockIdx.x == (unsigned)(F.G - 1)) {
        f32x2* rope = (f32x2*)(ws + WS_ROPE);
        for (int idx = F.tid; idx < 1024; idx += 512) {
            const int pos = idx >> 4, i = idx & 15;
            double f = 1.0; for (int q = 0; q < i; ++q) f *= 0.56234132519034908;
            double a = (double)pos * f; const double TWO_PI = 6.283185307179586476925;
            a -= TWO_PI * __builtin_floor(a * (1.0 / TWO_PI) + 0.5);
            double cs = 1.0, sn = a, tc = 1.0, tsn = a; const double a2 = a * a;
#pragma unroll
            for (int q = 1; q < 24; ++q) { tc *= a2 * (-1.0 / (double)((2 * q - 1) * (2 * q))); tsn *= a2 * (-1.0 / (double)((2 * q) * (2 * q + 1))); cs += tc; sn += tsn; }
            rope[idx] = (f32x2){(float)cs, (float)sn};
        }
        { float* gam = (float*)(ws + WS_GAM); const int jl = F.tid >> 8, w = (F.tid >> 6) & 3, d = F.tid & 63;
          const float* src = w == 0 ? inp(F, I_QNA) : w == 1 ? inp(F, I_KNA) : w == 2 ? inp(F, I_QNB) : inp(F, I_KNB); gam[F.tid] = src[jl * 64 + d]; }
    }
    {
        LAS float* scr = (LAS float*)(F.lds + F.wave * 16384);
        const int gw = blockIdx.x * 8 + F.wave, NGW = F.G * 8;
        constexpr int I_AIN = 16 * (1536 / 32), I_SQ = 16 * (1024 / 32), I_CIN = 16 * (3072 / 32);
        constexpr int NSMALL = 2 * (I_AIN + I_SQ + I_CIN + I_SQ), NITEMS = NSMALL + 48 * I_SQ;
        for (int it = gw; it < NITEMS; it += NGW) {
            if (it >= NSMALL) break;
            int r = it; const int j = r >= NSMALL / 2 ? 1 : 0; r -= j * (NSMALL / 2);
            if (r < I_AIN) { p0_transpose_item(inp(F, I_AWIN) + (size_t)j * 1024 * 1536, 1536, (bf16_t*)(ws + WS_WAIN + (size_t)j * 1536 * 1024), RM_AIN, scr, r, F.lane, true); continue; } r -= I_AIN;
            if (r < I_SQ) { p0_transpose_item(inp(F, I_AWOUT) + (size_t)j * 1024 * 1024, 1024, (bf16_t*)(ws + WS_WAOUT + (size_t)j * 1024 * 1024), RM_P8, scr, r, F.lane, true); continue; } r -= I_SQ;
            if (r < I_CIN) { p0_transpose_item(inp(F, I_CWIN) + (size_t)j * 1024 * 3072, 3072, (bf16_t*)(ws + WS_WCIN) + (size_t)j * 3072 * 1024, RM_CIN, scr, r, F.lane); continue; } r -= I_CIN;
            p0_transpose_item(inp(F, I_CWOUT) + (size_t)j * 1024 * 1024, 1024, (bf16_t*)(ws + WS_WCOUT) + (size_t)j * 1024 * 1024, RM_P8, scr, r, F.lane);
        }
        moe_convert_run(F, 0, gw, CV0_PRO, NGW, scr);
    }
}

__device__ __forceinline__ bf16_t* x_row_ptr(Frame& F, int row) { return (bf16_t*)(F.ws + WS_X) + (size_t)row * D; }
struct RowReq { u32x2 x[4]; unsigned w[4][4]; unsigned long long rest; unsigned ts; int row; unsigned vm; };
__device__ __forceinline__ const GAS unsigned* y_row_ptr(Frame& F, int row, int e, unsigned slot) {
    const bool lat = row < NLAT; const int b = lat ? (row >> 11) : ((row - NLAT) >> 8);
    const int T = lat ? e * 16 + b : 256 + e * 2 + (b >> 3);
    return (const GAS unsigned*)(F.ws + WS_Y + ((size_t)T * 256 + slot) * D) + F.lane;
}
__device__ __forceinline__ void y_add4(f32x4& v, unsigned w) {
    constexpr float r = 1.0f / pg8::SC_Y;
    v[0] += __builtin_amdgcn_cvt_f32_fp8((int)w, 0) * r; v[1] += __builtin_amdgcn_cvt_f32_fp8((int)w, 1) * r; v[2] += __builtin_amdgcn_cvt_f32_fp8((int)w, 2) * r; v[3] += __builtin_amdgcn_cvt_f32_fp8((int)w, 3) * r;
}
__device__ __forceinline__ void row_issue(Frame& F, RowReq& R, int row, unsigned ts) {
    R.row = row; R.ts = ts;
    const GAS u32x2* xr = (const GAS u32x2*)x_row_ptr(F, row) + F.lane;
#pragma unroll
    for (int j = 0; j < 4; ++j) R.x[j] = xr[64 * j];
    unsigned long long mask = __ballot(ts != 0xFFFFu);
    unsigned vm = 0u;
#pragma unroll
    for (int k = 0; k < 4; ++k) {
        const bool has = mask != 0ull;
        const int e = has ? __builtin_ctzll(mask) : 0;
        const unsigned sl = (unsigned)__builtin_amdgcn_readlane((int)ts, e);
        mask &= mask - 1ull;
        const GAS unsigned* y = y_row_ptr(F, row, has ? e : 0, has ? sl : 0u);
#pragma unroll
        for (int j = 0; j < 4; ++j) R.w[k][j] = y[64 * j];
        vm |= has ? (1u << k) : 0u;
    }
    R.vm = vm; R.rest = mask;
}
__device__ __forceinline__ void row_consume(Frame& F, const RowReq& R, f32x4 (&v)[4]) {
#pragma unroll
    for (int j = 0; j < 4; ++j) v[j] = (f32x4){bf_lo(R.x[j].x), bf_hi(R.x[j].x), bf_lo(R.x[j].y), bf_hi(R.x[j].y)};
#pragma unroll
    for (int k = 0; k < 4; ++k)
        if ((R.vm >> k) & 1u) {
#pragma unroll
            for (int j = 0; j < 4; ++j) y_add4(v[j], R.w[k][j]); }
    unsigned long long mask = R.rest;
    while (mask) {
        const int e = __builtin_ctzll(mask); mask &= mask - 1;
        const GAS unsigned* y = y_row_ptr(F, R.row, e, (unsigned)__builtin_amdgcn_readlane((int)R.ts, e));
#pragma unroll
        for (int j = 0; j < 4; ++j) { const unsigned ww = y[64 * j]; y_add4(v[j], ww); }
    }
}
struct RowRq { u32x4 x[2]; u32x4 w[8]; unsigned long long rest; unsigned ts; int row; unsigned vm; };
__device__ __forceinline__ const GAS u32x4* y_row_ptr16(Frame& F, int row, int e, unsigned slot) {
    const bool lat = row < NLAT; const int b = lat ? (row >> 11) : ((row - NLAT) >> 8);
    const int T = lat ? e * 16 + b : 256 + e * 2 + (b >> 3);
    return (const GAS u32x4*)(F.ws + WS_Y + ((size_t)T * 256 + slot) * D) + F.lane;
}
__device__ __forceinline__ void rowrq_issue(Frame& F, RowRq& R, int row, unsigned ts) {
    R.row = row; R.ts = ts;
    const GAS u32x4* xr = (const GAS u32x4*)x_row_ptr(F, row) + 2 * F.lane;
    R.x[0] = xr[0]; R.x[1] = xr[1];
    unsigned long long mask = __ballot(ts != 0xFFFFu);
    unsigned vm = 0u;
#pragma unroll
    for (int k = 0; k < 8; ++k) {
        const bool has = mask != 0ull;
        const int e = has ? __builtin_ctzll(mask) : 0;
        const unsigned sl = (unsigned)__builtin_amdgcn_readlane((int)ts, e);
        mask &= mask - 1ull;
        R.w[k] = *y_row_ptr16(F, row, has ? e : 0, has ? sl : 0u);
        vm |= has ? (1u << k) : 0u;
    }
    R.vm = vm; R.rest = mask;
}
__device__ __forceinline__ void rowrq_consume(Frame& F, const RowRq& R, f32x4 (&v)[4]) {
#pragma unroll
    for (int h = 0; h < 2; ++h) { const u32x4 x = R.x[h]; v[2 * h] = (f32x4){bf_lo(x.x), bf_hi(x.x), bf_lo(x.y), bf_hi(x.y)}; v[2 * h + 1] = (f32x4){bf_lo(x.z), bf_hi(x.z), bf_lo(x.w), bf_hi(x.w)}; }
#pragma unroll
    for (int k = 0; k < 8; ++k)
        if ((R.vm >> k) & 1u) {
#pragma unroll
            for (int q = 0; q < 4; ++q) y_add4(v[q], R.w[k][q]); }
    unsigned long long mask = R.rest;
    while (mask) {
        const int e = __builtin_ctzll(mask); mask &= mask - 1;
        const u32x4 ww = *y_row_ptr16(F, R.row, e, (unsigned)__builtin_amdgcn_readlane((int)R.ts, e));
#pragma unroll
        for (int q = 0; q < 4; ++q) y_add4(v[q], ww[q]);
    }
}
__device__ __forceinline__ void tokslot_preload(Frame& F, LAS unsigned short* strip, int rbeg, int nk) {
    const unsigned short* tokslot = (const unsigned short*)(F.ws + WS_TOKSLOT);
    if (F.lane < 16) {
        unsigned short t[18];
#pragma unroll
        for (int k = 0; k < 18; ++k) t[k] = k < nk ? tokslot[(size_t)F.lane * NROWS + rbeg + k] : (unsigned short)0xFFFFu;
#pragma unroll
        for (int k = 0; k < 18; ++k) strip[k * 16 + F.lane] = t[k];
    }
    LDS_WAIT(); asm volatile("" ::: "memory");
}
__device__ __forceinline__ void x_load_row(const bf16_t* xr, int lane, f32x4 (&v)[4]) {
#pragma unroll
    for (int j = 0; j < 4; ++j) { const u32x2 w = ((const GAS u32x2*)xr)[lane + 64 * j]; v[j] = (f32x4){bf_lo(w.x), bf_hi(w.x), bf_lo(w.y), bf_hi(w.y)}; }
}
__device__ __forceinline__ void x_store_row(bf16_t* xr, int lane, const f32x4 (&v)[4]) {
#pragma unroll
    for (int j = 0; j < 4; ++j) { u32x2 w; w.x = pk2(v[j][0], v[j][1]); w.y = pk2(v[j][2], v[j][3]); ((GAS u32x2*)xr)[lane + 64 * j] = w; }
}

__device__ __forceinline__ void n1_finish(Frame& F, int L, int row, const f32x4 (&v)[4], const f32x4 (&gs)[4], const f32x4 (&sh)[4]) {
    bf16_t* H = (bf16_t*)(F.ws + WS_H);
    x_store_row(x_row_ptr(F, row), F.lane, v);
    float ss = 0.f;
#pragma unroll
    for (int j = 0; j < 4; ++j) ss += (v[j][0] * v[j][0] + v[j][1] * v[j][1]) + (v[j][2] * v[j][2] + v[j][3] * v[j][3]);
    const float rinv = __builtin_amdgcn_rsqf(wave_sum(ss) * (1.0f / D) + EPS);
    if ((L & 1) == 0) {
        GAS unsigned* o4 = (GAS unsigned*)((unsigned char*)H + (size_t)row * D) + F.lane;
#pragma unroll
        for (int j = 0; j < 4; ++j) { const f32x4 h = ((v[j] * rinv) * gs[j] + sh[j]) * pg8::SC_H2; o4[64 * j] = pg8::pack4_fp8(h[0], h[1], h[2], h[3]); }
    } else {
        GAS u32x2* o8 = (GAS u32x2*)(H + (size_t)row * D) + F.lane;
#pragma unroll
        for (int j = 0; j < 4; ++j) { const f32x4 h = (v[j] * rinv) * gs[j] + sh[j]; u32x2 w; w.x = pk2(h[0], h[1]); w.y = pk2(h[2], h[3]); o8[64 * j] = w; }
    }
}
__device__ __forceinline__ void n1_finish16(Frame& F, int L, int row, const f32x4 (&v)[4], const f32x4 (&gs)[4], const f32x4 (&sh)[4]) {
    { GAS u32x4* xo = (GAS u32x4*)x_row_ptr(F, row) + 2 * F.lane;
#pragma unroll
      for (int h = 0; h < 2; ++h) { u32x4 w; w.x = pk2(v[2 * h][0], v[2 * h][1]); w.y = pk2(v[2 * h][2], v[2 * h][3]); w.z = pk2(v[2 * h + 1][0], v[2 * h + 1][1]); w.w = pk2(v[2 * h + 1][2], v[2 * h + 1][3]); xo[h] = w; } }
    float ss = 0.f;
#pragma unroll
    for (int j = 0; j < 4; ++j) ss += (v[j][0] * v[j][0] + v[j][1] * v[j][1]) + (v[j][2] * v[j][2] + v[j][3] * v[j][3]);
    const float rinv = __builtin_amdgcn_rsqf(wave_sum(ss) * (1.0f / D) + EPS);
    if ((L & 1) == 0) {
        u32x4 o;
#pragma unroll
        for (int q = 0; q < 4; ++q) { const f32x4 h = ((v[q] * rinv) * gs[q] + sh[q]) * pg8::SC_H2; o[q] = pg8::pack4_fp8(h[0], h[1], h[2], h[3]); }
        *((GAS u32x4*)((unsigned char*)(F.ws + WS_H) + (size_t)row * D) + F.lane) = o;
    } else {
        GAS u32x4* ho = (GAS u32x4*)((bf16_t*)(F.ws + WS_H) + (size_t)row * D) + 2 * F.lane;
#pragma unroll
        for (int hh = 0; hh < 2; ++hh) { const f32x4 h0 = (v[2 * hh] * rinv) * gs[2 * hh] + sh[2 * hh], h1 = (v[2 * hh + 1] * rinv) * gs[2 * hh + 1] + sh[2 * hh + 1];
            u32x4 w; w.x = pk2(h0[0], h0[1]); w.y = pk2(h0[2], h0[3]); w.z = pk2(h1[0], h1[1]); w.w = pk2(h1[2], h1[3]); ho[hh] = w; }
    }
}
__device__ __forceinline__ void n1_phase(const Frame& F0, int L, int nrows) {
    PHASE_FRAME(F0);
    const int gw = blockIdx.x * 8 + F.wave, NGW = F.G * 8, RPW = nrows / NGW, rbeg = gw * RPW;
    const float* gn = inp(F, I_N1G) + L * 1024; const float* modL = (const float*)(F.ws + WS_MOD) + (size_t)L * 17 * 6144;
    LAS unsigned short* strip = (LAS unsigned short*)F.lds + F.wave * 512;
    f32x4 gs[4], sh[4]; int bcur = -1;
#define N1_MOD(row) do { const int bm_ = (row) < NLAT ? ((row) >> 11) : 16; \
        if (bm_ != bcur) { bcur = bm_; const float* mrow = modL + bm_ * 6144;     \
            _Pragma("unroll") for (int j = 0; j < 4; ++j) { const int c = 4 * F.lane + 256 * j; gs[j] = *(const f32x4*)(gn + c) * (*(const f32x4*)(mrow + 1024 + c) + 1.0f); sh[j] = *(const f32x4*)(mrow + c); } } } while (0)
    if (L == 0) {
#define N1_XIN(r) ((r) < NLAT ? inp(F, I_X) + (size_t)(r) * D : inp(F, I_CTX) + (size_t)((r) - NLAT) * D)
#define N1_XLD(X, r) do { const GAS f32x4* xin_ = (const GAS f32x4*)N1_XIN(r) + F.lane; _Pragma("unroll") for (int j = 0; j < 4; ++j) X[j] = xin_[64 * j]; } while (0)
#define N1_STEP0(XC, XI, kk) do { const int k_ = (kk), row_ = rbeg + k_; N1_MOD(row_); N1_XLD(XI, rbeg + (k_ + 2 < RPW ? k_ + 2 : RPW - 1)); n1_finish(F, L, row_, XC, gs, sh); } while (0)
        f32x4 X0[4], X1[4], X2[4];
        N1_XLD(X0, rbeg); N1_XLD(X1, rbeg + 1);
        int k = 0;
        for (; k + 2 < RPW; k += 3) { N1_STEP0(X0, X2, k); N1_STEP0(X1, X0, k + 1); N1_STEP0(X2, X1, k + 2); }
        if (k < RPW) { N1_STEP0(X0, X2, k); if (k + 1 < RPW) N1_STEP0(X1, X0, k + 1); }
#undef N1_STEP0
#undef N1_XLD
#undef N1_XIN
    } else {
        tokslot_preload(F, strip, rbeg, RPW);
#define N1_MOD16(row) do { const int bm_ = (row) < NLAT ? ((row) >> 11) : 16; \
        if (bm_ != bcur) { bcur = bm_; const float* mrow = modL + bm_ * 6144;     \
            _Pragma("unroll") for (int q = 0; q < 4; ++q) { const int c = 16 * F.lane + 4 * q; gs[q] = *(const f32x4*)(gn + c) * (*(const f32x4*)(mrow + 1024 + c) + 1.0f); sh[q] = *(const f32x4*)(mrow + c); } } } while (0)
#define N1_ISSUE(R, kk) do { const int kn_ = (kk) < RPW ? (kk) : RPW - 1; rowrq_issue(F, R, rbeg + kn_, F.lane < 16 ? (unsigned)strip[kn_ * 16 + F.lane] : 0xFFFFu); } while (0)
#define N1_STEP(RC, RI, kk) do { const int k_ = (kk), row_ = rbeg + k_; N1_MOD16(row_); N1_ISSUE(RI, k_ + 2); f32x4 v_[4]; rowrq_consume(F, RC, v_); n1_finish16(F, L, row_, v_, gs, sh); } while (0)
        RowRq R0, R1, R2;
        N1_ISSUE(R0, 0); N1_ISSUE(R1, 1);
        int k = 0;
        for (; k + 2 < RPW; k += 3) { N1_STEP(R0, R2, k); N1_STEP(R1, R0, k + 1); N1_STEP(R2, R1, k + 2); }
        if (k < RPW) { N1_STEP(R0, R2, k); if (k + 1 < RPW) N1_STEP(R1, R0, k + 1); }
#undef N1_STEP
#undef N1_MOD16
#undef N1_ISSUE
    }
#undef N1_MOD
}
__device__ __forceinline__ void fin_phase(const Frame& F0) {
    PHASE_FRAME(F0);
    const int gw = blockIdx.x * 8 + F.wave, NGW = F.G * 8, RPW = NLAT / NGW, rbeg = gw * RPW;
    LAS unsigned short* strip = (LAS unsigned short*)F.lds + F.wave * 512;
    tokslot_preload(F, strip, rbeg, RPW);
    LAS unsigned char* stg = F.lds + 16384 + F.wave * 5120;
#define FIN_ISSUE(R, kk) do { const int kn_ = (kk) < RPW ? (kk) : RPW - 1; rowrq_issue(F, R, rbeg + kn_, F.lane < 16 ? (unsigned)strip[kn_ * 16 + F.lane] : 0xFFFFu); } while (0)
#define FIN_STEP(RC, RI, kk) do { const int k_ = (kk), row_ = rbeg + k_; FIN_ISSUE(RI, k_ + 2); f32x4 v_[4]; rowrq_consume(F, RC, v_); float* orow = F.out + (size_t)row_ * D; \
        _Pragma("unroll") for (int q = 0; q < 4; ++q) *(LAS f32x4*)(stg + F.lane * 80 + 16 * q) = v_[q]; \
        LDS_WAIT(); asm volatile("" ::: "memory"); \
        _Pragma("unroll") for (int j = 0; j < 4; ++j) { const int cq = F.lane + 64 * j; ((GAS f32x4*)orow)[cq] = *(const LAS f32x4*)(stg + (cq >> 2) * 80 + (cq & 3) * 16); } \
        asm volatile("" ::: "memory"); } while (0)
    RowRq R0, R1, R2;
    FIN_ISSUE(R0, 0); FIN_ISSUE(R1, 1);
    int k = 0;
    for (; k + 2 < RPW; k += 3) { FIN_STEP(R0, R2, k); FIN_STEP(R1, R0, k + 1); FIN_STEP(R2, R1, k + 2); }
    if (k < RPW) { FIN_STEP(R0, R2, k); if (k + 1 < RPW) FIN_STEP(R1, R0, k + 1); }
#undef FIN_STEP
#undef FIN_ISSUE
}
__device__ __forceinline__ void n2_phase(const Frame& F0, int L, int nrows) {
    PHASE_FRAME(F0);
    LAS unsigned short* WH = (LAS unsigned short*)F.lds;
    LAS unsigned short* WL = WH + 16384;
    LAS float* PSS = (LAS float*)(F.lds + 65536);
    LAS float* PLG = (LAS float*)(F.lds + 65536 + 1024);
    { const GAS float* rw = (const GAS float*)(inp(F, I_RW) + (size_t)L * 1024 * 16) + F.tid;
      float wv[32];
#pragma unroll
      for (int i = 0; i < 32; ++i) wv[i] = rw[512 * i];
#pragma unroll
      for (int i = 0; i < 32; ++i) { const int idx = F.tid + 512 * i, k = idx >> 4, e = idx & 15; const float w = wv[i];
          const unsigned hi = pk2(w, 0.f) & 0xffffu; const float rem = w - bf_lo(hi); const int o = ((k >> 3) * 16 + e) * 8 + (k & 7);
          WH[o] = (unsigned short)hi; WL[o] = (unsigned short)(pk2(rem, 0.f) & 0xffffu); } }
    __syncthreads();
    const float* gn = inp(F, I_N2G) + L * 1024; const float* modL = (const float*)(F.ws + WS_MOD) + (size_t)L * 17 * 6144;
    unsigned char* H8 = F.ws + WS_H; float* AFF = (float*)(F.ws + WS_AFF); const bf16_t* X = (const bf16_t*)(F.ws + WS_X);
    const int RPB = nrows / F.G, NG = RPB / 16, rb = (int)blockIdx.x * RPB;
    const int r = F.lane & 15, kg = F.lane >> 4, c0 = 128 * F.wave + 8 * kg;
    u32x4 nraw[4];
#pragma unroll
    for (int s_ = 0; s_ < 4; ++s_) nraw[s_] = *(const GAS u32x4*)(X + (size_t)(rb + r) * D + c0 + 32 * s_);
    f32x4 gs[4][2], sh[4][2];
    for (int g = 0; g < NG;) {
      int gend = NG;
      { const int row0_ = rb + 16 * g, bm = row0_ < NLAT ? (row0_ >> 11) : 16; const float* mrow = modL + bm * 6144;
        if (row0_ < NLAT) { const int ge = ((((row0_ >> 11) + 1) << 11) - rb) >> 4; gend = ge < NG ? ge : NG; }
#pragma unroll
        for (int s_ = 0; s_ < 4; ++s_)
#pragma unroll
            for (int q = 0; q < 2; ++q) { const int c = c0 + 32 * s_ + 4 * q; gs[s_][q] = *(const GAS f32x4*)(gn + c) * (*(const GAS f32x4*)(mrow + 4 * 1024 + c) + 1.0f); sh[s_][q] = *(const GAS f32x4*)(mrow + 3 * 1024 + c); } }
      for (; g < gend; ++g) {
        const int row0 = rb + 16 * g, row = row0 + r, par = g & 1;
        f32x4 v[4][2];
#pragma unroll
        for (int s_ = 0; s_ < 4; ++s_) { v[s_][0] = (f32x4){bf_lo(nraw[s_].x), bf_hi(nraw[s_].x), bf_lo(nraw[s_].y), bf_hi(nraw[s_].y)}; v[s_][1] = (f32x4){bf_lo(nraw[s_].z), bf_hi(nraw[s_].z), bf_lo(nraw[s_].w), bf_hi(nraw[s_].w)}; }
        if (g + 1 < NG) {
#pragma unroll
            for (int s_ = 0; s_ < 4; ++s_) nraw[s_] = *(const GAS u32x4*)(X + (size_t)(row + 16) * D + c0 + 32 * s_);
        }
        float ss = 0.f;
#pragma unroll
        for (int s_ = 0; s_ < 4; ++s_)
#pragma unroll
            for (int q = 0; q < 2; ++q) ss += (v[s_][q][0] * v[s_][q][0] + v[s_][q][1] * v[s_][q][1]) + (v[s_][q][2] * v[s_][q][2] + v[s_][q][3] * v[s_][q][3]);
        ss += __shfl_xor(ss, 16); ss += __shfl_xor(ss, 32);
        if (kg == 0) PSS[(par * 8 + F.wave) * 16 + r] = ss;
        __syncthreads();
        float tot = 0.f;
#pragma unroll
        for (int w = 0; w < 8; ++w) tot += PSS[(par * 8 + w) * 16 + r];
        const float rinv = __builtin_amdgcn_rsqf(tot * (1.0f / D) + EPS);
        u32x4 ahi[4], alo[4];
#pragma unroll
        for (int s_ = 0; s_ < 4; ++s_) {
            const f32x4 h0 = (v[s_][0] * rinv) * gs[s_][0] + sh[s_][0], h1 = (v[s_][1] * rinv) * gs[s_][1] + sh[s_][1];
            u32x4 hi; hi.x = pk2(h0[0], h0[1]); hi.y = pk2(h0[2], h0[3]); hi.z = pk2(h1[0], h1[1]); hi.w = pk2(h1[2], h1[3]);
            { u32x2 h8; h8.x = pg8::pack4_fp8(h0[0] * pg8::SC_H2, h0[1] * pg8::SC_H2, h0[2] * pg8::SC_H2, h0[3] * pg8::SC_H2); h8.y = pg8::pack4_fp8(h1[0] * pg8::SC_H2, h1[1] * pg8::SC_H2, h1[2] * pg8::SC_H2, h1[3] * pg8::SC_H2);
              *(GAS u32x2*)(H8 + (size_t)row * D + c0 + 32 * s_) = h8; } ahi[s_] = hi;
            alo[s_].x = pk2(h0[0] - bf_lo(hi.x), h0[1] - bf_hi(hi.x)); alo[s_].y = pk2(h0[2] - bf_lo(hi.y), h0[3] - bf_hi(hi.y));
            alo[s_].z = pk2(h1[0] - bf_lo(hi.z), h1[1] - bf_hi(hi.z)); alo[s_].w = pk2(h1[2] - bf_lo(hi.w), h1[3] - bf_hi(hi.w)); }
        f32x4 acc = (f32x4){0.f, 0.f, 0.f, 0.f};
#pragma unroll
        for (int s_ = 0; s_ < 4; ++s_) { const int o = ((16 * F.wave + 4 * s_ + kg) * 16 + r) * 8;
            const bf16x8 bh = *(const LAS bf16x8*)(WH + o), bl = *(const LAS bf16x8*)(WL + o);
            const bf16x8 ah = __builtin_bit_cast(bf16x8, ahi[s_]), al = __builtin_bit_cast(bf16x8, alo[s_]);
            acc = __builtin_amdgcn_mfma_f32_16x16x32_bf16(ah, bh, acc, 0, 0, 0);
            acc = __builtin_amdgcn_mfma_f32_16x16x32_bf16(ah, bl, acc, 0, 0, 0);
            acc = __builtin_amdgcn_mfma_f32_16x16x32_bf16(al, bh, acc, 0, 0, 0); }
#pragma unroll
        for (int i = 0; i < 4; ++i) PLG[((par * 8 + F.wave) * 16 + 4 * kg + i) * 16 + r] = acc[i];
        __syncthreads();
        if (F.lane < 32) { const int rl = 2 * F.wave + (F.lane >> 4), e = F.lane & 15; float lg = 0.f;
#pragma unroll
            for (int w = 0; w < 8; ++w) lg += PLG[((par * 8 + w) * 16 + rl) * 16 + e];
            float mx = lg;
#pragma unroll
            for (int o = 1; o < 16; o <<= 1) mx = fmaxf(mx, __shfl_xor(mx, o));
            const float ex = __expf(lg - mx); float den = ex;
#pragma unroll
            for (int o = 1; o < 16; o <<= 1) den += __shfl_xor(den, o);
            AFF[(size_t)(row0 + rl) * 16 + e] = ex / den; }
      }
    }
    __syncthreads();
}

__device__ __forceinline__ int blk_sum(LAS int* buf, int wave, int lane, int v_wave_total) {
    if (lane == 0) buf[wave] = v_wave_total;
    __syncthreads();
    int t = 0;
#pragma unroll
    for (int w = 0; w < 8; ++w) t += buf[w];
    return t;
}
__device__ __forceinline__ void tk_phase(const Frame& F0, bool with_ctx) {
    PHASE_FRAME(F0);
    LAS int* cb = (LAS int*)F.lds;
    const float* AFF = (const float*)(F.ws + WS_AFF);
    unsigned* IDX = (unsigned*)(F.ws + WS_IDX); float* GATE = (float*)(F.ws + WS_GATE); unsigned short* TOKSLOT = (unsigned short*)(F.ws + WS_TOKSLOT);
    for (int p = blockIdx.x; p < 256; p += F.G) {
        const int e = p >> 4, b = p & 15, row0 = b * SEQ, crow0 = NLAT + b * CTXL;
        const bool cw = with_ctx && F.wave == 0;
        unsigned key[4], ckey[4];
#pragma unroll
        for (int k = 0; k < 4; ++k) { key[k] = __float_as_uint(AFF[(size_t)(row0 + 4 * F.tid + k) * 16 + e]); ckey[k] = cw ? __float_as_uint(AFF[(size_t)(crow0 + 4 * F.lane + k) * 16 + e]) : 0u; }
        unsigned T = 0u, Tc = 0u;
        for (int bit = 29; bit >= 1; bit -= 2) {
            const unsigned c1 = T | (2u << bit), c2 = T | (1u << bit), c3 = T | (3u << bit);
            int n1 = 0, n2 = 0, n3 = 0;
#pragma unroll
            for (int k = 0; k < 4; ++k) { n1 += __popcll(__ballot(key[k] >= c1)); n2 += __popcll(__ballot(key[k] >= c2)); n3 += __popcll(__ballot(key[k] >= c3)); }
            if (cw) { const unsigned d1 = Tc | (2u << bit), d2 = Tc | (1u << bit), d3 = Tc | (3u << bit); int m1 = 0, m2 = 0, m3 = 0;
#pragma unroll
                for (int k = 0; k < 4; ++k) { m1 += __popcll(__ballot(ckey[k] >= d1)); m2 += __popcll(__ballot(ckey[k] >= d2)); m3 += __popcll(__ballot(ckey[k] >= d3)); }
                Tc = m3 >= 32 ? d3 : m1 >= 32 ? d1 : m2 >= 32 ? d2 : Tc; }
            LAS int* buf = cb + 64 + ((bit >> 1) & 3) * 24;
            if (F.lane == 0) { buf[F.wave * 3] = n1; buf[F.wave * 3 + 1] = n2; buf[F.wave * 3 + 2] = n3; }
            __syncthreads();
            int t1 = 0, t2 = 0, t3 = 0;
#pragma unroll
            for (int w = 0; w < 8; ++w) { t1 += buf[w * 3]; t2 += buf[w * 3 + 1]; t3 += buf[w * 3 + 2]; }
            T = t3 >= 256 ? c3 : t1 >= 256 ? c1 : t2 >= 256 ? c2 : T;
        }
        { const unsigned cand = T | 1u;
            int c = 0;
#pragma unroll
            for (int k = 0; k < 4; ++k) c += __popcll(__ballot(key[k] >= cand));
            if (cw) { const unsigned cc = Tc | 1u; int n = 0;
#pragma unroll
                for (int k = 0; k < 4; ++k) n += __popcll(__ballot(ckey[k] >= cc));
                if (n >= 32) Tc = cc; }
            const int tot = blk_sum(cb, F.wave, F.lane, c);
            if (tot >= 256) T = cand;
        }
        const unsigned long long lt = (1ull << F.lane) - 1ull;
        if (cw) {
            int ngt = 0;
#pragma unroll
            for (int k = 0; k < 4; ++k) ngt += __popcll(__ballot(ckey[k] > Tc));
            const int need = 32 - ngt; int run = 0;
#pragma unroll
            for (int k = 0; k < 4; ++k) run += __popcll(__ballot(ckey[k] == Tc) & lt);
            bool sel[4];
#pragma unroll
            for (int k = 0; k < 4; ++k) { const bool iseq = ckey[k] == Tc; sel[k] = (ckey[k] > Tc) || (iseq && run < need); run += iseq ? 1 : 0; }
            int slot = 0;
#pragma unroll
            for (int k = 0; k < 4; ++k) slot += __popcll(__ballot(sel[k]) & lt);
            const int tile = 256 + e * 2 + (b >> 3), sbase = (b & 7) * 32;
#pragma unroll
            for (int k = 0; k < 4; ++k) { const int t = 4 * F.lane + k; unsigned short ts = 0xFFFFu;
                if (sel[k]) { const int s_ = sbase + slot; ts = (unsigned short)s_; const size_t S = (size_t)tile * 256 + s_;
                    IDX[S] = (unsigned)(crow0 + t) * 1024u; GATE[S] = __uint_as_float(ckey[k]); ++slot; }
                TOKSLOT[(size_t)e * NROWS + crow0 + t] = ts; }
        }
        int cgt = 0;
#pragma unroll
        for (int k = 0; k < 4; ++k) cgt += __popcll(__ballot(key[k] > T));
        const int ngt = blk_sum(cb + 32, F.wave, F.lane, cgt);
        const int need = 256 - ngt;
        unsigned long long mq[4]; int weq = 0, leq = 0;
#pragma unroll
        for (int k = 0; k < 4; ++k) { mq[k] = __ballot(key[k] == T); weq += __popcll(mq[k]); leq += __popcll(mq[k] & lt); }
        if (F.lane == 0) cb[40 + F.wave] = weq;
        __syncthreads();
        int eqbase = leq;
        for (int w = 0; w < F.wave; ++w) eqbase += cb[40 + w];
        bool sel[4]; int run = eqbase;
#pragma unroll
        for (int k = 0; k < 4; ++k) { const bool iseq = key[k] == T; sel[k] = (key[k] > T) || (iseq && run < need); run += iseq ? 1 : 0; }
        unsigned long long ms[4]; int wsel = 0, lsel = 0;
#pragma unroll
        for (int k = 0; k < 4; ++k) { ms[k] = __ballot(sel[k]); wsel += __popcll(ms[k]); lsel += __popcll(ms[k] & lt); }
        if (F.lane == 0) cb[48 + F.wave] = wsel;
        __syncthreads();
        int slot = lsel;
        for (int w = 0; w < F.wave; ++w) slot += cb[48 + w];
#pragma unroll
        for (int k = 0; k < 4; ++k) { const int t = 4 * F.tid + k; unsigned short ts = 0xFFFFu;
            if (sel[k]) { ts = (unsigned short)slot; const size_t S = (size_t)p * 256 + slot;
                IDX[S] = (unsigned)(row0 + t) * 1024u;   GATE[S] = __uint_as_float(key[k]); ++slot; }
            TOKSLOT[(size_t)e * NROWS + row0 + t] = ts; }
        __syncthreads();
    }
}

__device__ __forceinline__ void conv_phase(const Frame& F0, int jl, int nrows) {
    PHASE_FRAME(F0);
    const int gw = blockIdx.x * 8 + F.wave, NGW = F.G * 4, RPW = nrows / NGW, rbeg = (gw >> 1) * RPW, c0 = 512 * (gw & 1) + 8 * F.lane;
    const bf16_t* BG = (const bf16_t*)(F.ws + WS_BG) + c0; const bf16_t* U = (const bf16_t*)(F.ws + WS_U) + c0; bf16_t* H = (bf16_t*)(F.ws + WS_H) + c0;
    const float* ck = inp(F, I_CK) + (size_t)jl * 3 * 1024 + c0; const float* cbias = inp(F, I_CB) + (size_t)jl * 1024 + c0;
    f32x4 k0[2], k1[2], k2[2], cb[2];
#pragma unroll
    for (int q = 0; q < 2; ++q) { k0[q] = *(const f32x4*)(ck + 4 * q); k1[q] = *(const f32x4*)(ck + 1024 + 4 * q); k2[q] = *(const f32x4*)(ck + 2048 + 4 * q); cb[q] = *(const f32x4*)(cbias + 4 * q); }
    u32x4 U0, U1, U2, U3, U4, U5, B0, B1, B2, B3, B4, B5;
    const int rlast = rbeg + RPW < nrows ? rbeg + RPW : nrows - 1;
#define CV_LDU(UB, i) do { int r_ = rbeg + (i); r_ = r_ < 0 ? 0 : (r_ > rlast ? rlast : r_); UB = *(const GAS u32x4*)(U + (size_t)r_ * D); } while (0)
#define CV_LDB(BB, i) do { const int r_ = rbeg + ((i) < RPW ? (i) : RPW - 1); BB = *(const GAS u32x4*)(BG + (size_t)r_ * D); } while (0)
#define CV_STEP(i, UP, UC, UN, UI, BC, BI) do { const int i_ = (i), row = rbeg + i_; CV_LDU(UI, i_ + 4); CV_LDB(BI, i_ + 3); \
        const bool lat = row < NLAT; const int t = lat ? (row & (SEQ - 1)) : ((row - NLAT) & (CTXL - 1)), n = lat ? SEQ : CTXL; const bool hp = t > 0, hn = t < n - 1; \
        u32x4 o; \
        _Pragma("unroll") for (int q = 0; q < 4; ++q) { const int h = q >> 1, e = 2 * (q & 1); \
            const float p0 = hp ? bf_lo(UP[q]) : 0.f, p1 = hp ? bf_hi(UP[q]) : 0.f, n0 = hn ? bf_lo(UN[q]) : 0.f, n1 = hn ? bf_hi(UN[q]) : 0.f; \
            const float y0 = k0[h][e] * p0 + k1[h][e] * bf_lo(UC[q]) + k2[h][e] * n0 + cb[h][e]; \
            const float y1 = k0[h][e + 1] * p1 + k1[h][e + 1] * bf_hi(UC[q]) + k2[h][e + 1] * n1 + cb[h][e + 1]; \
            o[q] = pk2(bf_lo(BC[q]) * y0, bf_hi(BC[q]) * y1); } \
        *(GAS u32x4*)(H + (size_t)row * D) = o; } while (0)
    CV_LDU(U5, -1); CV_LDU(U0, 0); CV_LDU(U1, 1); CV_LDB(B0, 0); CV_LDU(U2, 2); CV_LDB(B1, 1); CV_LDU(U3, 3); CV_LDB(B2, 2);
    int i = 0;
    for (; i + 5 < RPW; i += 6) {
        CV_STEP(i,     U5, U0, U1, U4, B0, B3); CV_STEP(i + 1, U0, U1, U2, U5, B1, B4); CV_STEP(i + 2, U1, U2, U3, U0, B2, B5);
        CV_STEP(i + 3, U2, U3, U4, U1, B3, B0); CV_STEP(i + 4, U3, U4, U5, U2, B4, B1); CV_STEP(i + 5, U4, U5, U0, U3, B5, B2);
    }
    if (i < RPW) { CV_STEP(i, U5, U0, U1, U4, B0, B3);
        if (i + 1 < RPW) { CV_STEP(i + 1, U0, U1, U2, U5, B1, B4);
            if (i + 2 < RPW) { CV_STEP(i + 2, U1, U2, U3, U0, B2, B5);
                if (i + 3 < RPW) { CV_STEP(i + 3, U2, U3, U4, U1, B3, B0);
                    if (i + 4 < RPW) { CV_STEP(i + 4, U3, U4, U5, U2, B4, B1); } } } } }
#undef CV_STEP
#undef CV_LDB
#undef CV_LDU
}

__device__ __forceinline__ void att_naive_phase(const Frame& F0, int jl) {
    PHASE_FRAME(F0);
    bf16_t* Q = (bf16_t*)(F.ws + WS_Q); const bf16_t* K = (const bf16_t*)(F.ws + WS_K); const bf16_t* V = (const bf16_t*)(F.ws + WS_V);
    LAS unsigned* Kt = (LAS unsigned*)F.lds; LAS unsigned* Vt = Kt + 2048;
    const int qi = F.tid & 255, half = F.wave >> 2;
    for (int u = blockIdx.x; u < 2304; u += F.G) {
        int type, b, h, qrow, qcol, kvcol, qpos, ts = 0, NT; float sink2 = -INFINITY;
        if (u < 2048) { type = u >> 10; const int w = u & 1023; b = w >> 6; h = (w >> 3) & 7; const int qc = w & 7; qpos = qc * 256 + qi; qrow = b * SEQ + qpos;
            qcol = (type * 8 + h) * HD; kvcol = (type * 2 + (h >> 2)) * HD;
            if (type == 0) NT = 36; else { const int t0 = qc * 4; ts = t0 - 2 < 0 ? 0 : t0 - 2; const int te = t0 + 6 > 32 ? 32 : t0 + 6; NT = 4 + (te - ts); sink2 = inp(F, I_SINK)[jl * 8 + h] * LOG2E; } }
        else { type = 2; const int w = u - 2048; b = w >> 4; const int g = (w >> 3) & 1; h = w & 7; qpos = qi; qrow = NLAT + b * CTXL + qpos;
            qcol = (g * 8 + h) * HD; kvcol = (g * 2 + (h >> 2)) * HD; NT = 4; if (g) sink2 = inp(F, I_SINK)[jl * 8 + h] * LOG2E; }
        const int kvrow0 = b * KVLEN;
        float o[32]; u32x4 qk[8];
        { const u32x4* qp = (const u32x4*)(Q + (size_t)qrow * D + qcol);
#pragma unroll
          for (int i = 0; i < 8; ++i) qk[i] = qp[i]; }
#pragma unroll
        for (int d = 0; d < 32; ++d) o[d] = 0.f;
        float m = -1e30f, l = 0.f;
        for (int ti = 0; ti < NT; ++ti) {
            int tile; bool band = false;
            if (type == 0) tile = ti; else if (ti < 4) tile = 32 + ti; else { tile = ts + (ti - 4); band = true; }
            __syncthreads();
            { const int r = F.tid >> 3, c = F.tid & 7; const size_t off = (size_t)(kvrow0 + tile * 64 + r) * KVP + kvcol + c * 8;
              *(LAS u32x4*)(Kt + r * 32 + c * 4) = *(const u32x4*)(K + off); *(LAS u32x4*)(Vt + r * 32 + c * 4) = *(const u32x4*)(V + off); }
            __syncthreads();
#pragma unroll 1
            for (int kq = 0; kq < 16; ++kq) {
                float s[4];
#pragma unroll
                for (int i = 0; i < 8; ++i) asm volatile("" : "+v"(qk[i]));
#pragma unroll
                for (int kk = 0; kk < 4; ++kk) { const LAS u32x4* kp = (const LAS u32x4*)(Kt + (kq * 4 + kk) * 32); float a = 0.f;
#pragma unroll
                    for (int i = 0; i < 8; ++i) { const u32x4 w = kp[i];
#pragma unroll
                        for (int c = 0; c < 4; ++c) { a += bf_lo(qk[i][c]) * bf_lo(w[c]); a += bf_hi(qk[i][c]) * bf_hi(w[c]); } }
                    if (band) { const int kpos = tile * 64 + kq * 4 + kk, dd = kpos - qpos; if (dd > 128 || dd < -128) a = -1e30f; }
                    s[kk] = a; }
                const float cm = fmaxf(fmaxf(s[0], s[1]), fmaxf(s[2], s[3]));
                const float mn = fmaxf(m, cm), sc = __builtin_amdgcn_exp2f(m - mn);
                l *= sc;
#pragma unroll
                for (int d = 0; d < 32; ++d) o[d] *= sc;
#pragma unroll
                for (int kk = 0; kk < 4; ++kk) { const float p = __builtin_amdgcn_exp2f(s[kk] - mn); l += p; const LAS u32x4* vp = (const LAS u32x4*)(Vt + (kq * 4 + kk) * 32 + half * 16);
#pragma unroll
                    for (int i = 0; i < 4; ++i) { const u32x4 w = vp[i];
#pragma unroll
                        for (int c = 0; c < 4; ++c) { o[8 * i + 2 * c] += p * bf_lo(w[c]); o[8 * i + 2 * c + 1] += p * bf_hi(w[c]); } } }
                m = mn;
                asm volatile("" ::: "memory");
            }
        }
        l += __builtin_amdgcn_exp2f(sink2 - m);
        const float rl = 1.0f / l;
        __syncthreads();
        { u32x4* op = (u32x4*)((bf16_t*)(F.ws + WS_H) + (size_t)qrow * D + qcol + half * 32);
#pragma unroll
            for (int i = 0; i < 4; ++i) { u32x4 w;
#pragma unroll
                for (int c = 0; c < 4; ++c) w[c] = pk2(o[8 * i + 2 * c] * rl, o[8 * i + 2 * c + 1] * rl);
                op[i] = w; } }
    }
    __syncthreads();
}

namespace attn_body {
using bf16=__hip_bfloat16;
using bf16x8=__attribute__((ext_vector_type(8)))short;
using s16x4=__attribute__((ext_vector_type(4)))short;
using f32x16=__attribute__((ext_vector_type(16)))float;
using u32x4=__attribute__((ext_vector_type(4)))unsigned;
constexpr int D=64,DM=1024,KVPT=256;
constexpr int NW=8,QBLK=32,QB=QBLK*NW,KVBLK=64;
__device__ __forceinline__ int crow(int r,int hi){return (r&3)+8*(r>>2)+4*hi;}
#define SBAR() __builtin_amdgcn_sched_barrier(0)
__device__ __forceinline__ void wmask(f32x16&p0,f32x16&p1,int krel,int qrel,int hi,int wid){
  const int dlo=krel-(32*wid+31), dhi=krel+63-32*wid;
  if(dlo>=-128&&dhi<=128)return;
  float xf=(float)(krel+4*hi-qrel); asm volatile("":"+v"(xf));
  #pragma unroll
  for(int r=0;r<16;++r){const float c=(float)((r&3)+8*(r>>2));
    p0[r]=__builtin_fmaf(__builtin_fminf(128.f-__builtin_fabsf(xf+c),0.f),1e30f,p0[r]);
    p1[r]=__builtin_fmaf(__builtin_fminf(128.f-__builtin_fabsf(xf+(c+32.f)),0.f),1e30f,p1[r]);}
}
struct AttU { int qrow0,qcol,kvrow0,kvcol,NT,tA,nA,tB,nband,krel0,wqm,whs,hs; float skv; };

constexpr int NSLOT=3, SLOTB=8192;
constexpr int LDS_K=0, LDS_V=NSLOT*SLOTB, LDS_WS=2*NSLOT*SLOTB, LDS_OST=LDS_WS+NW*64*4, LDS_BYTES=LDS_OST+NW*4096;
__device__ __forceinline__ void glds16(const void*gsrc,unsigned lds_dst){unsigned keep;
  asm volatile("s_mov_b32 %0, m0\n\ts_mov_b32 m0, %2\n\ts_nop 0\n\tglobal_load_lds_dwordx4 %1, off\n\ts_mov_b32 m0, %0":"=&s"(keep):"v"(gsrc),"s"(lds_dst):"memory");}
__device__ __forceinline__ float max3f(float a,float b,float c){float r;asm("v_max3_f32 %0, %1, %2, %3":"=v"(r):"v"(a),"v"(b),"v"(c));return r;}
__device__ __forceinline__ float max2f(float a,float b){float r;asm("v_max_f32_e32 %0, %1, %2":"=v"(r):"v"(a),"v"(b));return r;}
__device__ __forceinline__ float fadd_s(float a,float b){float r;asm("v_add_f32_e32 %0, %1, %2":"=v"(r):"v"(a),"v"(b));return r;}
__device__ __forceinline__ float fsub_s(float a,float b){float r;asm("v_sub_f32_e32 %0, %1, %2":"=v"(r):"v"(a),"v"(b));return r;}
typedef float f32x2_t __attribute__((ext_vector_type(2))); typedef __bf16 bf16x2_t __attribute__((ext_vector_type(2)));
__device__ __forceinline__ unsigned cvtpk_s(float lo,float hi){f32x2_t v={lo,hi};bf16x2_t b=__builtin_convertvector(v,bf16x2_t);return __builtin_bit_cast(unsigned,b);}
#define WAIT_BAR(N) asm volatile("s_waitcnt vmcnt(" #N ") lgkmcnt(0)\n\ts_barrier":::"memory")

__device__ __forceinline__ void qkt(f32x16&p0,f32x16&p1,const char*Kslot,const bf16x8*qr,const f32x16&negm,int r32,int hi){
  const char*kb=Kslot+hi*1024+r32*16;
  #pragma unroll
  for(int d0=0;d0<4;++d0){
    const bf16x8 b0=*reinterpret_cast<const bf16x8*>(kb+d0*2048);
    const bf16x8 b1=*reinterpret_cast<const bf16x8*>(kb+d0*2048+512);
    if(d0==0){p0=__builtin_amdgcn_mfma_f32_32x32x16_bf16(b0,qr[0],negm,0,0,0);p1=__builtin_amdgcn_mfma_f32_32x32x16_bf16(b1,qr[0],negm,0,0,0);}
    else{p0=__builtin_amdgcn_mfma_f32_32x32x16_bf16(b0,qr[d0],p0,0,0,0);p1=__builtin_amdgcn_mfma_f32_32x32x16_bf16(b1,qr[d0],p1,0,0,0);}}
}
typedef __attribute__((address_space(3))) const char* lds_cptr;
typedef short v4i16_t __attribute__((ext_vector_type(4)));
__device__ __forceinline__ void kload8(bf16x8*kf,lds_cptr kp){
  kf[0]=*(const __attribute__((address_space(3))) bf16x8*)(kp);      kf[1]=*(const __attribute__((address_space(3))) bf16x8*)(kp+512);
  kf[2]=*(const __attribute__((address_space(3))) bf16x8*)(kp+2048); kf[3]=*(const __attribute__((address_space(3))) bf16x8*)(kp+2560);
  kf[4]=*(const __attribute__((address_space(3))) bf16x8*)(kp+4096); kf[5]=*(const __attribute__((address_space(3))) bf16x8*)(kp+4608);
  kf[6]=*(const __attribute__((address_space(3))) bf16x8*)(kp+6144); kf[7]=*(const __attribute__((address_space(3))) bf16x8*)(kp+6656);
}
__device__ __forceinline__ void kload2(bf16x8*kf,lds_cptr kp,int j){ kf[2*j]=*(const __attribute__((address_space(3))) bf16x8*)(kp+j*2048); kf[2*j+1]=*(const __attribute__((address_space(3))) bf16x8*)(kp+j*2048+512); }
__device__ __forceinline__ s16x4 vtr(lds_cptr p){ return __builtin_bit_cast(s16x4,__builtin_amdgcn_ds_read_tr16_b64_v4i16((__attribute__((address_space(3))) v4i16_t*)p)); }
__device__ __forceinline__ float rowmax(const f32x16&p0,const f32x16&p1){
  float a=max3f(p0[0],p0[1],p1[0]),b=max3f(p0[2],p0[3],p1[1]);a=max3f(a,p1[2],p1[3]);
  #pragma unroll
  for(int r=4;r<16;r+=4){a=max3f(a,p0[r],p0[r+1]);b=max3f(b,p0[r+2],p0[r+3]);a=max3f(a,p1[r],p1[r+1]);b=max3f(b,p1[r+2],p1[r+3]);}
  const float m=max2f(a,b);
  auto rr=__builtin_amdgcn_permlane32_swap(__float_as_uint(m),__float_as_uint(m),false,false);
  return max2f(__uint_as_float(rr[0]),__uint_as_float(rr[1]));
}
__device__ __forceinline__ void pv(f32x16*o,int vb,bf16x8 pa0,bf16x8 pa1,bf16x8 pa2,bf16x8 pa3){
  #pragma unroll
  for(int d0=0;d0<2;++d0){s16x4 lo[4],hi[4];
    #pragma unroll
    for(int ks=0;ks<4;++ks){
      asm volatile("ds_read_b64_tr_b16 %0,%1 offset:%c2":"=&v"(lo[ks]):"v"(vb),"i"(d0*4096+ks*1024):"memory");
      asm volatile("ds_read_b64_tr_b16 %0,%1 offset:%c2":"=&v"(hi[ks]):"v"(vb),"i"(d0*4096+ks*1024+512):"memory");}
    asm volatile("s_waitcnt lgkmcnt(0)":::"memory");SBAR();
    #define PK(k) (bf16x8){lo[k][0],lo[k][1],lo[k][2],lo[k][3],hi[k][0],hi[k][1],hi[k][2],hi[k][3]}
    o[d0]=__builtin_amdgcn_mfma_f32_32x32x16_bf16(pa0,PK(0),o[d0],0,0,0);
    o[d0]=__builtin_amdgcn_mfma_f32_32x32x16_bf16(pa1,PK(1),o[d0],0,0,0);
    o[d0]=__builtin_amdgcn_mfma_f32_32x32x16_bf16(pa2,PK(2),o[d0],0,0,0);
    o[d0]=__builtin_amdgcn_mfma_f32_32x32x16_bf16(pa3,PK(3),o[d0],0,0,0);
    #undef PK
  }
}

#ifndef ATTN_STORE16
#define ATTN_STORE16(p,v) (*(u32x4*)(p)=(v))
#endif
template<int THRL> __device__ __forceinline__ void attn_unit(const AttU&U,const bf16*Q,const bf16*__restrict__ K,const bf16*__restrict__ V,bf16*O,char*shm){
  int tid_=threadIdx.x; asm volatile("":"+v"(tid_)); const int tid=tid_,lane=tid&63,r32=lane&31,hi=lane>>5; const int wid=__builtin_amdgcn_readfirstlane(tid>>6);
  const int NT=U.NT,nA=U.nA,tA=U.tA,tB=U.tB,nband=U.nband,krel0=U.krel0;
  const int wq=wid&U.wqm, wh=wid>>U.whs;
  const bf16*Qw=Q+((long)U.qrow0+wq*QBLK)*DM+U.qcol+wh*D;
  const bf16*Kh=K+(long)U.kvrow0*KVPT+U.kvcol,*Vh=V+(long)U.kvrow0*KVPT+U.kvcol;
  const unsigned lds0=(unsigned)(uintptr_t)shm;
  float*wsf=(float*)(shm+LDS_WS)+wid*64;
  const bf16*ksrc=Kh+(long)lane*KVPT+wid*8;
  const bf16*vsrc=Vh+(long)(16*(wid&3)+(lane>>2))*KVPT+(wid>>2)*32+(lane&3)*8;
  const unsigned kdst=lds0+LDS_K+wid*1024, vdst=lds0+LDS_V+wid*1024;
  #define TILE(t) ((t)<nA?tA+(t):tB+((t)-nA))
  #define DMA_K(t,slot) glds16(ksrc+(long)TILE(t)*(KVBLK*KVPT),(unsigned)__builtin_amdgcn_readfirstlane(kdst+(slot)))
  #define DMA_V(t,slot) glds16(vsrc+(long)TILE(t)*(KVBLK*KVPT),(unsigned)__builtin_amdgcn_readfirstlane(vdst+(slot)))
  const int vb0=(int)(lds0+LDS_V)+((lane>>4)&1)*32+(lane&3)*8+(4*hi+((lane&15)>>2))*64;
  const char*Kbase=shm+LDS_K; bf16x8 kf[8];
  const lds_cptr shm3=(lds_cptr)shm; const lds_cptr kp0=shm3+LDS_K+hi*1024+r32*16; const lds_cptr vp0=shm3+LDS_V+((lane>>4)&1)*32+(lane&3)*8+(4*hi+((lane&15)>>2))*64;
  DMA_K(0,0);DMA_V(0,0);DMA_K(1,SLOTB);
  bf16x8 qr[4];
  #pragma unroll
  for(int d0=0;d0<4;++d0)qr[d0]=*reinterpret_cast<const bf16x8*>(&Qw[(long)r32*DM+d0*16+hi*8]);
  float mhat=0.f,l_reg=0.f;f32x16 o[2];o[0]=f32x16{};o[1]=f32x16{};f32x16 negm=f32x16{};asm volatile("":"+v"(negm));
  const int qrel=wq*QBLK+r32;
  #define CMASK(P0,P1,t) do{int jb_=(t)-(NT-nband); if(jb_>=0)wmask(P0,P1,krel0+64*jb_,qrel,hi,wq);}while(0)
  bool resc=false;
  #define START(P0,P1) do{ const float rm=rowmax(P0,P1); resc=false; \
    { const float dl=rm; mhat=fadd_s(mhat,dl); \
      _Pragma("unroll") for(int r=0;r<16;++r){P0[r]=fsub_s(P0[r],dl);P1[r]=fsub_s(P1[r],dl);} \
      _Pragma("unroll") for(int r=0;r<16;++r)negm[r]=-mhat; asm volatile("":"+v"(negm)); } \
    _Pragma("unroll") for(int r=0;r<16;++r)P0[r]=__builtin_amdgcn_exp2f(P0[r]); }while(0)
  #define RESC() do{ if(resc){ asm volatile("s_waitcnt lgkmcnt(0)":::"memory"); \
      _Pragma("unroll") for(int d_=0;d_<2;++d_) _Pragma("unroll") for(int r=0;r<16;++r)o[d_][r]*=wsf[crow(r,hi)]; } }while(0)
  f32x16 pA0,pA1,pB0,pB1;
  int sl_prev=0,sl_cur=0,sl_next=SLOTB;
  #define ROT() do{sl_prev=sl_cur;sl_cur=sl_next;sl_next=(sl_next==(NSLOT-1)*SLOTB)?0:sl_next+SLOTB;}while(0)
  DMA_K(2,2*SLOTB);
  WAIT_BAR(3);
  qkt(pA0,pA1,Kbase,qr,negm,r32,hi);asm volatile("s_nop 15\n\ts_nop 7":"+v"(pA0),"+v"(pA1));CMASK(pA0,pA1,0);
  START(pA0,pA1);
  _Pragma("unroll") for(int r=0;r<16;++r)pA1[r]=__builtin_amdgcn_exp2f(pA1[r]);
  WAIT_BAR(0);
  DMA_K(3,0);DMA_V(1,SLOTB);
  ROT();
  kload8(kf,kp0+sl_cur);
  WAIT_BAR(2);
  s16x4 vlo[8],vhi[8]; u32x4 pw0,pw1,pw2,pw3;
  #define PKW(P,B) cvtpk_s(P[B],P[B+1])
  #define PAF(k) __builtin_bit_cast(bf16x8,pw##k)
  #define VFR(i) (bf16x8){vlo[i][0],vlo[i][1],vlo[i][2],vlo[i][3],vhi[i][0],vhi[i][1],vhi[i][2],vhi[i][3]}
  #define PIN(x) asm volatile("":"+v"(x))
  #define MX3(a,b,c) __builtin_fmaxf(__builtin_fmaxf((a),(b)),(c))
  #define GAPA(MF,A0,A1,A2,A3,W0,W1,PW) do{ MF; sacc+=A0; sacc+=A1; sacc+=A2; sacc+=A3; PIN(sacc); W0; W1; PIN(PW); SBAR(); }while(0)
  #define EX(v) __builtin_amdgcn_exp2f(v)
  #define GAPB(MF,X,B) do{ MF; X[B]=EX(X[B]); X[B+1]=EX(X[B+1]); X[B+2]=EX(X[B+2]); X[B+3]=EX(X[B+3]); PIN(X); SBAR(); }while(0)
  #define VRD(i) do{ vlo[i]=vtr(vp_+(((i)>>2)*4096+((i)&3)*1024)); vhi[i]=vtr(vp_+(((i)>>2)*4096+((i)&3)*1024+512)); }while(0)
  #define KRD(G,j) do{ if(G){ kload2(kf,kp0+sl_next,j); SBAR(); } }while(0)
  #define STEP(C0,C1,P0,P1,t,GK,GV,GL) do{ SBAR(); \
    const lds_cptr vp_=vp0+sl_prev; \
    VRD(0); SBAR(); float sacc=(P0[0]+P0[1]); \
    GAPA(C0=__builtin_amdgcn_mfma_f32_32x32x16_bf16(kf[0],qr[0],negm,0,0,0), P0[2],P0[3],P0[4],P0[5],     pw0[0]=PKW(P0,0), pw0[1]=PKW(P0,2), pw0); \
    VRD(4); SBAR(); GAPA(C1=__builtin_amdgcn_mfma_f32_32x32x16_bf16(kf[1],qr[0],negm,0,0,0), P0[6],P0[7],P0[8],P0[9],     pw0[2]=PKW(P0,4), pw0[3]=PKW(P0,6), pw0); \
    VRD(1); SBAR(); GAPA(C0=__builtin_amdgcn_mfma_f32_32x32x16_bf16(kf[2],qr[1],C0,0,0,0),   P0[10],P0[11],P0[12],P0[13], pw1[0]=PKW(P0,8), pw1[1]=PKW(P0,10), pw1); \
    VRD(5); SBAR(); GAPA(C1=__builtin_amdgcn_mfma_f32_32x32x16_bf16(kf[3],qr[1],C1,0,0,0),   P0[14],P0[15],P1[0],P1[1],   pw1[2]=PKW(P0,12),pw1[3]=PKW(P0,14), pw1); \
    VRD(2); SBAR(); GAPA(C0=__builtin_amdgcn_mfma_f32_32x32x16_bf16(kf[4],qr[2],C0,0,0,0),   P1[2],P1[3],P1[4],P1[5],     pw2[0]=PKW(P1,0), pw2[1]=PKW(P1,2), pw2); \
    VRD(6); SBAR(); GAPA(C1=__builtin_amdgcn_mfma_f32_32x32x16_bf16(kf[5],qr[2],C1,0,0,0),   P1[6],P1[7],P1[8],P1[9],     pw2[2]=PKW(P1,4), pw2[3]=PKW(P1,6), pw2); \
    VRD(3); SBAR(); GAPA(C0=__builtin_amdgcn_mfma_f32_32x32x16_bf16(kf[6],qr[3],C0,0,0,0),   P1[10],P1[11],P1[12],P1[13], pw3[0]=PKW(P1,8), pw3[1]=PKW(P1,10), pw3); \
    VRD(7); SBAR(); GAPA(C1=__builtin_amdgcn_mfma_f32_32x32x16_bf16(kf[7],qr[3],C1,0,0,0),   P1[14],P1[15],0.f,0.f,       pw3[2]=PKW(P1,12),pw3[3]=PKW(P1,14), pw3); \
    l_reg+=sacc; \
    if(GK){DMA_K((t)+3,sl_cur);} if(GV){DMA_V((t)+1,sl_next);} \
    CMASK(C0,C1,t); \
    { float a=MX3(C0[0],C0[1],C1[0]),b=MX3(C0[2],C0[3],C1[1]); a=MX3(a,C1[2],C1[3]); \
      _Pragma("unroll") for(int r=4;r<16;r+=4){a=MX3(a,C0[r],C0[r+1]);b=MX3(b,C0[r+2],C0[r+3]);a=MX3(a,C1[r],C1[r+1]);b=MX3(b,C1[r+2],C1[r+3]);} \
      float rm=__builtin_fmaxf(a,b); { auto rr=__builtin_amdgcn_permlane32_swap(__float_as_uint(rm),__float_as_uint(rm),false,false); rm=__builtin_fmaxf(__uint_as_float(rr[0]),__uint_as_float(rr[1])); } \
      resc=false; \
      if(__builtin_expect(__any(rm>(float)THRL),0)){ const float dl=__builtin_fmaxf(rm,0.f); mhat+=dl; \
        _Pragma("unroll") for(int r=0;r<16;++r){C0[r]-=dl;C1[r]-=dl;} \
        _Pragma("unroll") for(int r=0;r<16;++r)negm[r]=-mhat; asm volatile("":"+v"(negm)); \
        const float f=__builtin_amdgcn_exp2f(-dl); l_reg*=f; if(hi==0)wsf[r32]=f; resc=true; } } \
    SBAR(); \
    GAPB(o[0]=__builtin_amdgcn_mfma_f32_32x32x16_bf16(PAF(0),VFR(0),o[0],0,0,0), C0,0); \
    GAPB(o[1]=__builtin_amdgcn_mfma_f32_32x32x16_bf16(PAF(0),VFR(4),o[1],0,0,0), C0,4); \
    KRD(GL,0); GAPB(o[0]=__builtin_amdgcn_mfma_f32_32x32x16_bf16(PAF(1),VFR(1),o[0],0,0,0), C0,8); \
    KRD(GL,1); GAPB(o[1]=__builtin_amdgcn_mfma_f32_32x32x16_bf16(PAF(1),VFR(5),o[1],0,0,0), C0,12); \
    KRD(GL,2); GAPB(o[0]=__builtin_amdgcn_mfma_f32_32x32x16_bf16(PAF(2),VFR(2),o[0],0,0,0), C1,0); \
    KRD(GL,3); GAPB(o[1]=__builtin_amdgcn_mfma_f32_32x32x16_bf16(PAF(2),VFR(6),o[1],0,0,0), C1,4); \
    GAPB(o[0]=__builtin_amdgcn_mfma_f32_32x32x16_bf16(PAF(3),VFR(3),o[0],0,0,0), C1,8); \
    GAPB(o[1]=__builtin_amdgcn_mfma_f32_32x32x16_bf16(PAF(3),VFR(7),o[1],0,0,0), C1,12); \
    }while(0)
  int t=1;
  #undef CMASK
  #define CMASK(P0,P1,t) do{}while(0)
  const int tend=__builtin_amdgcn_readfirstlane((NT-5)<(NT-nband-1)?(NT-5):(NT-nband-1));
  for(;t<tend;t+=2){
    STEP(pB0,pB1,pA0,pA1,t,true,true,true);     WAIT_BAR(2); RESC(); ROT();
    STEP(pA0,pA1,pB0,pB1,t+1,true,true,true);   WAIT_BAR(2); RESC(); ROT();
  }
  #undef CMASK
  #define CMASK(P0,P1,t) do{int jb_=(t)-(NT-nband); if(jb_>=0)wmask(P0,P1,krel0+64*jb_,qrel,hi,wq);}while(0)
  #define ENDW(tt) do{ if((tt)+3<NT){WAIT_BAR(2);} else if((tt)+2<NT){WAIT_BAR(1);} else {WAIT_BAR(0);} }while(0)
  for(;t+1<NT;t+=2){
    STEP(pB0,pB1,pA0,pA1,t,(t+3<NT),(t+1<NT),(t+1<NT));       ENDW(t);   RESC(); ROT();
    STEP(pA0,pA1,pB0,pB1,t+1,(t+4<NT),(t+2<NT),(t+2<NT));     ENDW(t+1); RESC(); ROT();
  }
  STEP(pB0,pB1,pA0,pA1,NT-1,false,false,false); RESC();
  { float sacc=pB0[0]+pB0[1]; _Pragma("unroll") for(int r=2;r<16;++r)sacc+=pB0[r]; _Pragma("unroll") for(int r=0;r<16;++r)sacc+=pB1[r]; l_reg+=sacc;
    pw0=(u32x4){PKW(pB0,0),PKW(pB0,2),PKW(pB0,4),PKW(pB0,6)};pw1=(u32x4){PKW(pB0,8),PKW(pB0,10),PKW(pB0,12),PKW(pB0,14)};pw2=(u32x4){PKW(pB1,0),PKW(pB1,2),PKW(pB1,4),PKW(pB1,6)};pw3=(u32x4){PKW(pB1,8),PKW(pB1,10),PKW(pB1,12),PKW(pB1,14)};
    SBAR(); pv(o,vb0+sl_cur,PAF(0),PAF(1),PAF(2),PAF(3)); }
  #undef PKW
  #undef PAF
  #undef VFR
  #undef PIN
  #undef MX3
  #undef GAPA
  #undef GAPB
  #undef EX
  #undef VRD
  #undef KRD
  #undef STEP
  #undef ENDW
  {auto rr=__builtin_amdgcn_permlane32_swap(__float_as_uint(l_reg),__float_as_uint(l_reg),false,false);l_reg=__uint_as_float(rr[0])+__uint_as_float(rr[1]);}
  { const float sink2=__int_as_float(__builtin_amdgcn_readlane(__float_as_int(U.skv),U.hs+wh)); l_reg+=__builtin_amdgcn_exp2f(sink2-mhat); }
  if(hi==0)wsf[32+r32]=l_reg;asm volatile("s_waitcnt lgkmcnt(0)":::"memory");
  float rli[16];
  #pragma unroll
  for(int r=0;r<16;++r)rli[r]=__builtin_amdgcn_rcpf(wsf[32+crow(r,hi)]);
  unsigned char*Ow=(unsigned char*)O+((long)U.qrow0+wq*QBLK)*DM+U.qcol+wh*D;
  { unsigned char*stg=(unsigned char*)(shm+LDS_OST)+wid*4096;
    #pragma unroll
    for(int r=0;r<16;++r){const int orow=crow(r,hi);
      #pragma unroll
      for(int d0=0;d0<2;++d0){const float ov=__builtin_fminf(__builtin_fmaxf(o[d0][r]*rli[r]*64.f,-448.f),448.f); stg[orow*64+d0*32+r32]=(unsigned char)(__builtin_amdgcn_cvt_pk_fp8_f32(ov,ov,0,false)&0xff);}}
    asm volatile("s_waitcnt lgkmcnt(0)":::"memory");
    #pragma unroll
    for(int i=0;i<2;++i){const int row=i*16+(lane>>2),ch=lane&3; const u32x4 v=*(const u32x4*)(stg+row*64+ch*16); ATTN_STORE16(Ow+(long)row*DM+ch*16,v);} }
  asm volatile("s_waitcnt lgkmcnt(0)\n\ts_barrier":::"memory");
  #undef DMA_K
  #undef TILE
  #undef DMA_V
  #undef CMASK
  #undef START
  #undef RESC
  #undef ROT
}
constexpr int ATTN_LDS_BYTES=LDS_BYTES;
#undef SBAR
#undef WAIT_BAR
}
static_assert(attn_body::ATTN_LDS_BYTES <= RING_BYTES, "attention LDS");
__device__ __forceinline__ void att_fast_phase(const Frame& F0, int jl) {
    PHASE_FRAME(F0);
    const attn_body::bf16* Q = (const attn_body::bf16*)(F.ws + WS_Q); const attn_body::bf16* K = (const attn_body::bf16*)(F.ws + WS_K); const attn_body::bf16* V = (const attn_body::bf16*)(F.ws + WS_V);
    const float skv = F.lane < 8 ? ((const GAS float*)(inp(F, I_SINK) + jl * 8))[F.lane] * LOG2E : -INFINITY;
    for (int i = 0;; ++i) {
        const int lin = i * F.G + (int)blockIdx.x; if (lin >= 2304) break;
        const int slot = lin >> 8; int v = lin & 255; if (F.G == 256) v = (v & 7) * 32 + (v >> 3);
        attn_body::AttU U;
        U.wqm = 7; U.whs = 3; U.hs = 8; U.skv = skv;
        if (slot < 4) { const int bh = v >> 1, b = bh >> 3, h = bh & 7, qb = (v & 1) * 4 + slot;
            U.qrow0 = b * SEQ + qb * 256; U.qcol = h * HD; U.kvrow0 = b * KVLEN; U.kvcol = (h >> 2) * HD;
            U.NT = 36; U.tA = 0; U.nA = 36; U.tB = 0; U.nband = 0; U.krel0 = 0; }
        else if (slot < 8) { const int b = v >> 4, kvh = (v >> 3) & 1, q64 = (v & 7) * 4 + (slot & 3);
            int ts = q64 - 2 < 0 ? 0 : q64 - 2, te = q64 + 3 > 32 ? 32 : q64 + 3;
            if ((te - ts) & 1) { if (te < 32) ++te; else --ts; }
            const int nb = te - ts;
            U.qrow0 = b * SEQ + q64 * 64; U.qcol = (8 + 4 * kvh) * HD; U.kvrow0 = b * KVLEN; U.kvcol = (2 + kvh) * HD; U.wqm = 1; U.whs = 1;
            U.NT = 4 + nb; U.tA = 32; U.nA = 4; U.tB = ts; U.nband = nb; U.krel0 = ts * 64 - q64 * 64;
            U.hs = 4 * kvh; }
        else { const int b = v >> 4, g = (v >> 3) & 1, h = v & 7;
            U.qrow0 = NLAT + b * CTXL; U.qcol = (g * 8 + h) * HD; U.kvrow0 = b * KVLEN; U.kvcol = (g * 2 + (h >> 2)) * HD;
            U.NT = 4; U.tA = 32; U.nA = 4; U.tB = 0; U.nband = 0; U.krel0 = 0; if (g) U.hs = h; }
        attn_body::attn_unit<8>(U, Q, K, V, (attn_body::bf16*)(F.ws + WS_H), (char*)(unsigned char*)F.lds);
    }
}

constexpr int N_PHASES = 34;
struct Args { const float* in[23]; float* out; unsigned char* ws; int ph_lo, ph_hi; };
static_assert(sizeof(Args) == 23 * 8 + 8 + 8 + 8, "Args has no padding");

__global__ void __launch_bounds__(512, 2) mk_fwd(Args args) {
    extern __shared__ __attribute__((aligned(16))) unsigned char lds[];
    Frame F;
    F.lds = (LAS unsigned char*)lds;
    F.tid = threadIdx.x; F.lane = F.tid & 63; F.wave = __builtin_amdgcn_readfirstlane(F.tid >> 6); F.G = gridDim.x;
    F.out = args.out; F.ws = args.ws;
    unsigned char* ws = args.ws;
    volatile LAS unsigned* MISC = (volatile LAS unsigned*)(F.lds + MISC_OFF);
    for (int u = F.tid; u < (GTAB_OFF - LDSCTL_OFF) / 4; u += 512) ((LAS unsigned*)(F.lds + LDSCTL_OFF))[u] = 0u;
    __syncthreads();
    if (F.tid == 0) {
#pragma unroll
        for (int i = 0; i < 23; ++i) ((LAS unsigned long long*)(F.lds + PT_OFF))[i] = (unsigned long long)args.in[i];
    }
    __syncthreads();
    XcdBarrier bar; bar.bar = (unsigned*)(ws + WS_CTL) + CW_BAR; bar.x = 0; bar.st = nullptr;
#if !MK_PER_PHASE
    bar = xcd_barrier_post((unsigned*)(ws + WS_CTL) + CW_BAR, MISC + 8);
#endif
    const int lo = args.ph_lo, hi = args.ph_hi;
#define IN(k) (lo <= (k) && (k) < hi)
#if MK_PER_PHASE
#define SEAM(k) do { } while (0)
#else
#define SEAM(k) do { if (IN(k) && IN((k) + 1)) xcd_barrier(bar); } while (0)
#endif
    constexpr int krot = 0;
#define CV_C1(Lw) ((Lw) == 1 ? 13824 : (Lw) == 2 ? 12288 : 15360)
#define CV_C2(Lw) ((Lw) == 1 ? 20992 : (Lw) == 2 ? 18432 : 24576)
    const float* modAll = (const float*)(ws + WS_MOD);
    bf16_t* H = (bf16_t*)(ws + WS_H);

    if (IN(0)) { { p0_prologue(F); __syncthreads(); } } SEAM(0);

    for (int L = 0; L < DEPTH; ++L) {
        const int pb = 1 + 8 * L, jl = L >> 1;
        const bool with_ctx = L < DEPTH - 1;
        const int nrows = with_ctx ? NROWS : NLAT, nMt = nrows / 256;
        const float* modL = modAll + (size_t)L * 17 * 6144;


        if (IN(pb + 0)) {
            n1_phase(F, L, nrows); } SEAM(pb + 0);

        if ((L & 1) == 0) {
            if (IN(pb + 1)) {
                pg8::StaticOrder S; S.init(nMt, 6, F.G, (int)blockIdx.x);
                pg8::EpiAttnIn E{(bf16_t*)(ws + WS_Q), (bf16_t*)(ws + WS_K), (bf16_t*)(ws + WS_V), (const float*)(ws + WS_GAM) + jl * 256, (const f32x2*)(ws + WS_ROPE)};
                pg8::gemm_phase<pg8::EpiAttnIn, pg8::StaticOrder, false, true, PG8_SP2, true>(F.lds, H, (const bf16_t*)(ws + WS_WAIN + (size_t)jl * 1536 * 1024), nullptr, S, E, krot);
                if (blockIdx.x >= 96) moe_convert_slice(F, L, L == 0 ? CV0_PRO : CV_C2(L), 24576 - (L == 0 ? CV0_PRO : CV_C2(L)), (int)blockIdx.x - 96, 160);
            }
            SEAM(pb + 1);
            if (IN(pb + 2)) {
#if ATT_NAIVE
                att_naive_phase(F, jl);
#else
                att_fast_phase(F, jl);
#endif
            }
            SEAM(pb + 2);
        } else {
            if (IN(pb + 1)) {
                pg8::StaticOrder S; S.init(nMt, 12, F.G, (int)blockIdx.x);
                pg8::EpiConvIn E{(bf16_t*)(ws + WS_BG), (bf16_t*)(ws + WS_U)};
                pg8::gemm_phase<pg8::EpiConvIn, pg8::StaticOrder, false, true, PG8_SP2>(F.lds, H, (const bf16_t*)(ws + WS_WCIN) + (size_t)jl * 3072 * 1024, nullptr, S, E, krot);
                if (with_ctx && blockIdx.x >= 192) moe_convert_slice(F, L, CV_C2(L), 24576 - CV_C2(L), (int)blockIdx.x - 192, 64);
            }
            SEAM(pb + 1);
            if (IN(pb + 2)) { conv_phase(F, jl, nrows); }
            SEAM(pb + 2);
        }
        if (IN(pb + 3)) {
            pg8::StaticOrder S; S.init(nMt, 4, F.G, (int)blockIdx.x);
            if ((L & 1) == 0) {
                pg8::EpiResid E{(bf16_t*)(ws + WS_X), modL, 2 * 1024, 1.0f / (pg8::SC_O * pg8::SC_W)};
                pg8::gemm_phase<pg8::EpiResid, pg8::StaticOrder, false, true, PG8_SP2, true>(F.lds, (const bf16_t*)H, (const bf16_t*)(ws + WS_WAOUT + (size_t)jl * 1024 * 1024), nullptr, S, E, krot);
            } else {
                pg8::EpiResid E{(bf16_t*)(ws + WS_X), modL, 2 * 1024, 1.0f};
                pg8::gemm_phase<pg8::EpiResid, pg8::StaticOrder, false, true, PG8_SP2>(F.lds, (const bf16_t*)H, (const bf16_t*)(ws + WS_WCOUT) + (size_t)jl * 1024 * 1024, nullptr, S, E, krot);
            }
            if (with_ctx && blockIdx.x >= 64) moe_convert_slice(F, L + 1, 0, CV_C1(L + 1), (int)blockIdx.x - 64, 192);
        }
        SEAM(pb + 3);
        if (IN(pb + 4)) {
            { n2_phase(F, L, nrows); __syncthreads(); } } SEAM(pb + 4);
        if (IN(pb + 5)) { tk_phase(F, with_ctx); } SEAM(pb + 5);
        if (IN(pb + 6)) {
            pg8::UpOrder S; S.init(F.G, (int)blockIdx.x, with_ctx);
            LAS unsigned* gtab = (LAS unsigned*)(F.lds + GTAB_OFF);
            const unsigned* IDX = (const unsigned*)(ws + WS_IDX);
            { int t_ = threadIdx.x; asm volatile("" : "+v"(t_));
              if (t_ < 256) { unsigned gv_[9]; pg8::Unit u;
#pragma unroll
                  for (int i = 0; i < 9; ++i) gv_[i] = S.next(i, u) ? IDX[(size_t)u.pm * 256 + t_] : 0u;
#pragma unroll
                  for (int i = 0; i < 9; ++i) gtab[i * 256 + t_] = gv_[i]; } }
            __syncthreads();
            pg8::EpiUp E{ws + WS_HID};
            pg8::gemm_phase<pg8::EpiUp, pg8::UpOrder, true, true, PG8_SP2, true>(F.lds, (const bf16_t*)(ws + WS_H), (const bf16_t*)(ws + WS_WUP + (size_t)L * 16 * 2048 * 1024), gtab, S, E, krot);
        }
        SEAM(pb + 6);
        if (IN(pb + 7)) {
            pg8::DnOrder S; S.init(F.G, (int)blockIdx.x, with_ctx);
            pg8::EpiDown E{ws + WS_Y, (const float*)(ws + WS_GATE), modL};
            pg8::gemm_phase<pg8::EpiDown, pg8::DnOrder, false, true, PG8_SP2, true>(F.lds, (const bf16_t*)(ws + WS_HID), (const bf16_t*)(ws + WS_WDN + (size_t)L * 16 * 1024 * 1024), nullptr, S, E, krot);
            if (with_ctx && blockIdx.x >= 128) moe_convert_slice(F, L + 1, CV_C1(L + 1), CV_C2(L + 1) - CV_C1(L + 1), (int)blockIdx.x - 128, 128);
        }
        SEAM(pb + 7);
    }
    if (IN(33)) {
        fin_phase(F); }
#undef IN
#undef SEAM
}

extern "C" void kernel_launch(void* const* d_in, const int* in_sizes, int n_in, void* d_out, int out_size, void* d_ws, size_t ws_size, hipStream_t stream) {
    static int grid = 0;
    if (grid == 0) {
        if (n_in != 23 || out_size != NLAT * D || ws_size < WS_END) { fprintf(stderr, "kernel_launch: unexpected shapes (n_in %d, out %d, ws %zu)\n", n_in, out_size, ws_size); grid = -1; return; }
        int dev = 0, cus = 0, per_cu = 0;
        if (hipGetDevice(&dev) != hipSuccess || hipDeviceGetAttribute(&cus, hipDeviceAttributeMultiprocessorCount, dev) != hipSuccess) { grid = -1; return; }
        if (hipFuncSetAttribute((const void*)mk_fwd, hipFuncAttributeMaxDynamicSharedMemorySize, LDS_BYTES) != hipSuccess) { fprintf(stderr, "kernel_launch: hipFuncSetAttribute failed\n"); grid = -1; return; }
        if (hipOccupancyMaxActiveBlocksPerMultiprocessor(&per_cu, (const void*)mk_fwd, 512, LDS_BYTES) != hipSuccess || per_cu < 1) fprintf(stderr, "kernel_launch: occupancy query reports %d\n", per_cu);
        (void)hipGetLastError();
        if (cus < 256) { fprintf(stderr, "kernel_launch: %d CUs; this kernel's static deals need 256 resident workgroups; nothing launched\n", cus); grid = -1; return; }
        grid = 256;
    }
    if (grid < 0) return;
    (void)hipMemsetAsync((char*)d_ws + WS_CTL, 0, CTL_ZERO_BYTES, stream);
    Args a{};
    for (int i = 0; i < 23; ++i) a.in[i] = (const float*)d_in[i];
    a.out = (float*)d_out; a.ws = (unsigned char*)d_ws;
#if MK_PER_PHASE
    for (int p = 0; p < N_PHASES; ++p) { a.ph_lo = p; a.ph_hi = p + 1; hipLaunchKernelGGL(mk_fwd, dim3(grid), dim3(512), LDS_BYTES, stream, a); }
#else
    a.ph_lo = 0; a.ph_hi = N_PHASES;
    hipLaunchKernelGGL(mk_fwd, dim3(grid), dim3(512), LDS_BYTES, stream, a);
#endif
    const hipError_t le = hipPeekAtLastError();
    if (le != hipSuccess) fprintf(stderr, "kernel_launch: launch failed: %s\n", hipGetErrorName(le));
}
```

```cpp
#include <hip/hip_runtime.h>
#include <hip/hip_bf16.h>
#include <cstdio>
#include <cstdint>
#include <cmath>

#ifndef MK_PER_PHASE
#define MK_PER_PHASE 0
#endif
#ifndef PG8_SP2
#define PG8_SP2 true
#endif
#ifndef ATT_NAIVE
#define ATT_NAIVE 0
#endif

#define GAS __attribute__((address_space(1)))
#define LAS __attribute__((address_space(3)))
typedef unsigned short bf16_t;
typedef short bf16x8 __attribute__((ext_vector_type(8)));
typedef float f32x4 __attribute__((ext_vector_type(4)));
typedef float f32x2 __attribute__((ext_vector_type(2)));
typedef unsigned u32x4 __attribute__((ext_vector_type(4)));
typedef unsigned u32x2 __attribute__((ext_vector_type(2)));
typedef GAS unsigned gu32;
#define RLX_AGENT __ATOMIC_RELAXED, __HIP_MEMORY_SCOPE_AGENT

constexpr int D = 1024, NB = 16, SEQ = 2048, CTXL = 256, DEPTH = 4, HD = 64;
constexpr int NLAT = NB * SEQ, NCTX = NB * CTXL, NROWS = NLAT + NCTX;
constexpr int NE = 16, KVLEN = SEQ + CTXL  , KVP = 256  ;
constexpr int NSLOT_LAT = NB * NE * 256, NSLOT_ALL = NSLOT_LAT + NB * NE * 32;
constexpr float EPS = 1e-6f;
constexpr float C2 = 0.125f * 1.4426950408889634f;
constexpr float LOG2E = 1.4426950408889634f;

constexpr size_t MiB = 1u << 20;
constexpr size_t WS_CTL = 0, CTL_ZERO_BYTES = 64 * 1024;
constexpr size_t WS_MOD = 1 * MiB;
constexpr size_t WS_ROPE = 3 * MiB;
constexpr size_t WS_GAM = WS_ROPE + 8192;
constexpr size_t WS_IDX = 3 * MiB + 64 * 1024;
constexpr size_t WS_GATE = WS_IDX + 512 * 1024;
constexpr size_t WS_TOKSLOT = 4 * MiB + 512 * 1024;
constexpr size_t WS_AFF = 6 * MiB;
constexpr size_t WS_XCTX = 9 * MiB;
constexpr size_t WS_WAIN = 25 * MiB;
constexpr size_t WS_WAOUT = 31 * MiB;
constexpr size_t WS_WCIN = 35 * MiB;
constexpr size_t WS_WCOUT = 47 * MiB;
constexpr size_t WS_WUP = 51 * MiB;
constexpr size_t WS_WDN = 307 * MiB;
constexpr size_t WS_H = 435 * MiB;
constexpr size_t WS_MIX = 507 * MiB;
constexpr size_t WS_Q = WS_MIX, WS_K = WS_MIX + 72 * MiB, WS_V = WS_K + 18 * MiB;
constexpr size_t WS_BG = WS_MIX, WS_U = WS_MIX + 72 * MiB;
constexpr size_t WS_HID = WS_MIX;
constexpr size_t WS_Y = 651 * MiB;
constexpr size_t WS_X = 795 * MiB;
constexpr size_t WS_END = 867 * MiB;
static_assert(WS_TOKSLOT + (size_t)16 * NROWS * 2 <= WS_AFF && WS_AFF + (size_t)NROWS * 16 * 4 <= WS_XCTX && WS_GATE + (size_t)NSLOT_ALL * 4 <= WS_TOKSLOT, "ws map");
static_assert(WS_V + (size_t)NB * KVLEN * KVP * 2 <= WS_Y && WS_HID + (size_t)NSLOT_ALL * D * 2 <= WS_Y, "ws map 2");

constexpr int CW_BAR = 4096;

constexpr int RING_BYTES = 131072;
constexpr int LDSCTL_OFF = RING_BYTES, MISC_OFF = LDSCTL_OFF + 320;
constexpr int GTAB_OFF = RING_BYTES + 1024;
constexpr int LDS_BYTES = 147456;
static_assert(GTAB_OFF + 9 * 256 * 4 <= LDS_BYTES, "lds map");

#define LDS_WAIT() asm volatile("s_waitcnt lgkmcnt(0)" ::: "memory")
#define VM_WAIT() asm volatile("s_waitcnt vmcnt(0)" ::: "memory")
__device__ __forceinline__ unsigned f2bf(float f) { unsigned u = __builtin_bit_cast(unsigned, f); return (u + 0x7fffu + ((u >> 16) & 1u)) >> 16; }
__device__ __forceinline__ unsigned cvt_pk_bf16(float lo, float hi) { unsigned r; asm volatile("v_cvt_pk_bf16_f32 %0, %1, %2" : "=v"(r) : "v"(lo), "v"(hi)); return r; }
__device__ __forceinline__ unsigned pk2(float lo, float hi) { unsigned r; asm("v_cvt_pk_bf16_f32 %0, %1, %2" : "=v"(r) : "v"(lo), "v"(hi)); return r; }
__device__ __forceinline__ float bf_lo(unsigned w) { return __builtin_bit_cast(float, w << 16); }
__device__ __forceinline__ float bf_hi(unsigned w) { return __builtin_bit_cast(float, w & 0xffff0000u); }
__device__ __forceinline__ float wave_sum(float v) {
#pragma unroll
    for (int o = 1; o < 64; o <<= 1) v += __shfl_xor(v, o);
    return v;
}

#define XB_TMO      128
#define XB_XCNT(j)  (256  + 64 * (j))
#define XB_XSUB(j)  (1280 + 64 * (j))
#define XB_XGEN(j)  (2304 + 64 * (j))
#define XB_TOP      3328
#define XB_TOPGEN   3392
#define XCD_BAR_WORDS 3456
#define XB_SPIN_CAP (1u << 18)

__device__ __forceinline__ unsigned xb_ld(unsigned* p)              { return __hip_atomic_load(p, __ATOMIC_RELAXED, __HIP_MEMORY_SCOPE_AGENT); }
__device__ __forceinline__ unsigned xb_add(unsigned* p, unsigned v) { return __hip_atomic_fetch_add(p, v, __ATOMIC_RELAXED, __HIP_MEMORY_SCOPE_AGENT); }
__device__ __forceinline__ unsigned xb_xcc_id() { return (unsigned)__builtin_amdgcn_s_getreg((3 << 11) | 20) & 0xFu; }
#define XB_SPIN(cond, bar) do { unsigned _sp = 0; while (cond) { __builtin_amdgcn_s_sleep(1); \
    if ((++_sp & 255u) == 0u) { if (xb_ld(&(bar)[XB_TMO])) break; if (_sp > XB_SPIN_CAP) { atomicAdd(&(bar)[XB_TMO], 1u); break; } } } } while (0)

struct XcdBarrier { unsigned* bar; unsigned x; volatile LAS unsigned* st; };

__device__ __forceinline__ XcdBarrier xcd_barrier_post(unsigned* bar, volatile LAS unsigned* st) {
    XcdBarrier b; b.bar = bar; b.x = xb_xcc_id(); b.st = st;
    if (threadIdx.x == 0) (void)xb_add(&bar[XB_XCNT(b.x)], 1u);
    return b;
}
__device__ __forceinline__ void xcd_barrier_complete(unsigned* bar, unsigned x, unsigned& nloc, unsigned& nx) {
    const unsigned G = gridDim.x * gridDim.y * gridDim.z;
    unsigned sum, cnt, mine, sp = 0u;
    for (;;) {
        sum = 0u; cnt = 0u; mine = 0u;
#pragma unroll
        for (unsigned j = 0; j < 16; ++j) { const unsigned c = xb_ld(&bar[XB_XCNT(j)]); sum += c; cnt += (c > 0u) ? 1u : 0u; mine = (j == x) ? c : mine; }
        if (sum == G) break;
        __builtin_amdgcn_s_sleep(1);
        if ((++sp & 255u) == 0u) { if (xb_ld(&bar[XB_TMO])) break; if (sp > XB_SPIN_CAP) { atomicAdd(&bar[XB_TMO], 1u); break; } }
    }
    nloc = mine > 0u ? mine : 1u; nx = cnt > 0u ? cnt : 1u;
}
__device__ __forceinline__ void xcd_barrier(const XcdBarrier& b) {
    asm volatile("s_waitcnt vmcnt(0)" ::: "memory");
    __syncthreads();
    if (threadIdx.x == 0) {
        unsigned* bar = b.bar;
        __builtin_amdgcn_s_waitcnt(0);
        unsigned nloc = b.st[0], nx = b.st[1];
        if (nloc == 0u) { xcd_barrier_complete(bar, b.x, nloc, nx); b.st[0] = nloc; b.st[1] = nx; }
        const unsigned old = xb_add(&bar[XB_XSUB(b.x)], 1u);
        const unsigned gen = old / nloc;
        if (old + 1u == (gen + 1u) * nloc) {
            __builtin_amdgcn_fence(__ATOMIC_RELEASE, "agent");
            asm volatile("s_waitcnt vmcnt(0)" ::: "memory");
            const unsigned og = xb_add(&bar[XB_TOP], 1u);
            const unsigned tg = og / nx;
            if (og + 1u == (tg + 1u) * nx) xb_add(&bar[XB_TOPGEN], 1u);
            else XB_SPIN(xb_ld(&bar[XB_TOPGEN]) == tg, bar);
            __builtin_amdgcn_fence(__ATOMIC_ACQUIRE, "agent");
            xb_add(&bar[XB_XGEN(b.x)], 1u);
            asm volatile("s_waitcnt vmcnt(0)" ::: "memory");
        } else {
            XB_SPIN(xb_ld(&bar[XB_XGEN(b.x)]) == gen, bar);
            __builtin_amdgcn_fence(__ATOMIC_ACQUIRE, "agent");
            asm volatile("s_waitcnt vmcnt(0)" ::: "memory");
        }
    }
    __syncthreads();
}

namespace pg8 {
typedef int v8i32 __attribute__((ext_vector_type(8)));
typedef int i32x4 __attribute__((ext_vector_type(4)));
constexpr int BM = 256, BK = 64, HALF = 128, HTB = HALF * BK * 2, STAGE_BYTES = 8 * HTB, NXCD = 8, WGM = 8;
constexpr int KD = 1024;
__host__ __device__ __forceinline__ int lds_byte(int r, int c) { const int st = (r >> 4) * 2 + (c >> 5), rr = r & 15, cc = c & 31, ob = rr * 64 + cc * 2; return st * 1024 + (ob ^ (((ob >> 9) & 1) << 5)); }
__host__ __device__ __forceinline__ void stage_rc(int b, int& R, int& C) { const int st = b / 1024, sb = b % 1024, swz = sb ^ (((sb >> 9) & 1) << 5); R = (st >> 1) * 16 + swz / 64; C = (st & 1) * 32 + (swz % 64) / 2; }

struct Unit { int pm, pn; };
constexpr float SC_W = 256.f, SC_H2 = 8.f, SC_HID = 4.f, SC_Y = 64.f, SC_O = 64.f;
__device__ __forceinline__ float clamp448(float x) { return __builtin_fminf(__builtin_fmaxf(x, -448.f), 448.f); }
__device__ __forceinline__ unsigned pack4_fp8(float a, float b, float c, float d) {
    int p = __builtin_amdgcn_cvt_pk_fp8_f32(clamp448(a), clamp448(b), 0, false); p = __builtin_amdgcn_cvt_pk_fp8_f32(clamp448(c), clamp448(d), p, true); return (unsigned)p; }

struct StaticOrder {
    int nM, nN, nwg, G, c;
    __device__ __forceinline__ void init(int nM_, int nN_, int G_, int c_) { nM = nM_; nN = nN_; nwg = nM * nN; G = G_; c = c_; }
    __device__ __forceinline__ bool next(int i, Unit& u) const {
        const long L = (long)i * G + c; if (L >= nwg) return false;
        int wgid = (int)L; { const int q = nwg / NXCD, r = nwg % NXCD, xcd = wgid % NXCD, off = wgid / NXCD; wgid = (xcd < r ? xcd * (q + 1) : r * (q + 1) + (xcd - r) * q) + off; }
        const int nig = WGM * nN, gid = wgid / nig, fm = gid * WGM, gsz = (nM - fm) < WGM ? (nM - fm) : WGM;
        u.pm = fm + ((wgid % nig) % gsz); u.pn = (wgid % nig) / gsz; return true;
    }
};
struct UpOrder {
    int G, c, nunits;
    __device__ __forceinline__ void init(int G_, int c_, bool with_ctx) { G = G_; c = c_; nunits = with_ctx ? 2304 : 2048; }
    __device__ __forceinline__ bool next(int i, Unit& u) const {
        const int L = i * G + c; if (L >= nunits) return false;
        const int rnd = L >> 8, v = L & 255, x = v & 7, j = v >> 3;
        if (rnd < 8) { const int e = 2 * x + (rnd >> 2), b = 4 * (rnd & 3) + (j >> 3); u.pm = e * 16 + b; u.pn = e * 8 + (j & 7); }
        else { const int t = 4 * x + (j >> 3); u.pm = 256 + t; u.pn = (t >> 1) * 8 + (j & 7); }
        return true;
    }
};
struct DnOrder {
    int G, c, nunits;
    __device__ __forceinline__ void init(int G_, int c_, bool with_ctx) { G = G_; c = c_; nunits = with_ctx ? 1152 : 1024; }
    __device__ __forceinline__ bool next(int i, Unit& u) const {
        const int L = i * G + c; if (L >= nunits) return false;
        const int rnd = L >> 8, v = L & 255;
        if (rnd < 4) { const int x = v & 7, j = v >> 3, e = 2 * x + (rnd >> 1), b = 8 * (rnd & 1) + (j >> 2); u.pm = e * 16 + b; u.pn = e * 4 + (j & 3); }
        else { const int x = v & 7, j = v >> 3  , t = 4 * x + (j >> 2); u.pm = 256 + t; u.pn = (t >> 1) * 4 + (j & 3); }
        return true;
    }
};

template <class Epi, class Sched, bool GATHER, bool ALIGN_EPI, bool SP2, bool FP8 = false>
__device__ __forceinline__ void gemm_phase(LAS unsigned char* lds, const bf16_t* A, const bf16_t* Bt, const LAS unsigned* gtab, const Sched& S, const Epi& E, const int krot = 0) {
    int tid_ = threadIdx.x; asm volatile("" : "+v"(tid_));
    const int tid = tid_, wid = __builtin_amdgcn_readfirstlane(tid >> 6), lane = tid & 63, wr = wid >> 2, wc = wid & 3, fr = lane & 15, fq = lane >> 4;
    constexpr int ROWB = FP8 ? KD : 2 * KD  , nt = ROWB / 128;
    unsigned voffA[2], voffB[2]; int RA[2];
#pragma unroll
    for (int i = 0; i < 2; ++i) { int R, C; stage_rc(tid * 16 + i * 8192, R, C); RA[i] = R;
        voffA[i] = GATHER ? (unsigned)(C * 2) : (unsigned)(R * ROWB + C * 2); voffB[i] = (unsigned)(R * ROWB + C * 2); }
    constexpr size_t kstep = (size_t)(BK * 2);
#define PG8_KO(t) ((size_t)((((t) + krot) & (nt - 1))) * kstep)
    constexpr size_t hstep = (size_t)HALF * ROWB;
    constexpr size_t tstep = 2 * hstep;
    const unsigned ldsw = (unsigned)wid * 1024u;
    const int aoff = lds_byte(wr * 64 + fr, fq * 8), boff = lds_byte(wc * 32 + fr, fq * 8);
#define PG8_SA(b, h) (((b) * 2 + (h)) * HTB)
#define PG8_SB(b, h) ((4 + (b) * 2 + (h)) * HTB)
#define PG8_STAGE(bufoff, gbase, voff) do { const char* gb_ = (const char*)(gbase); asm volatile("" : "+s"(gb_));     \
        _Pragma("unroll") for (int _i = 0; _i < 2; ++_i) \
        __builtin_amdgcn_global_load_lds((const unsigned*)(gb_ + (voff)[_i]), (LAS unsigned*)(lds + (bufoff) + ldsw + _i * 8192), 16, 0, 0); } while (0)
#define PG8_STAGE_A(bufoff, gbase, h, vo) do { if constexpr (GATHER) { PG8_STAGE(bufoff, gbase, (vo)[h]); } else { PG8_STAGE(bufoff, (gbase) + (h) * hstep, voffA); } } while (0)
#define PG8_LDA(dst, b, h) do { _Pragma("unroll") for (int m = 0; m < 4; ++m) _Pragma("unroll") for (int k = 0; k < 2; ++k) dst[m][k] = *(const LAS bf16x8*)(lds + PG8_SA(b, h) + aoff + m * 2048 + k * 1024); } while (0)
#define PG8_LDB(dst, b, h) do { _Pragma("unroll") for (int n = 0; n < 2; ++n) _Pragma("unroll") for (int k = 0; k < 2; ++k) dst[n][k] = *(const LAS bf16x8*)(lds + PG8_SB(b, h) + boff + n * 2048 + k * 1024); } while (0)
#define PG8_MMA(ai, bj, At, Bt_, Z) do { __builtin_amdgcn_s_setprio(1); _Pragma("unroll") for (int m = 0; m < 4; ++m) _Pragma("unroll") for (int n = 0; n < 2; ++n) { \
        if constexpr (FP8) { const v8i32 a8 = __builtin_shufflevector(__builtin_bit_cast(i32x4, At[m][0]), __builtin_bit_cast(i32x4, At[m][1]), 0, 1, 2, 3, 4, 5, 6, 7); \
            const v8i32 b8 = __builtin_shufflevector(__builtin_bit_cast(i32x4, Bt_[n][0]), __builtin_bit_cast(i32x4, Bt_[n][1]), 0, 1, 2, 3, 4, 5, 6, 7); \
            if constexpr (Z) asm volatile("v_mfma_f32_16x16x128_f8f6f4 %0, %1, %2, 0" : "=&v"(acc[ai][bj][m][n]) : "v"(b8), "v"(a8));     \
            else asm volatile("v_mfma_f32_16x16x128_f8f6f4 %0, %1, %2, %0" : "+v"(acc[ai][bj][m][n]) : "v"(b8), "v"(a8)); }     \
        else { if constexpr (Z) { acc[ai][bj][m][n] = __builtin_amdgcn_mfma_f32_16x16x32_bf16(Bt_[n][0], At[m][0], (f32x4){0.f, 0.f, 0.f, 0.f}, 0, 0, 0); acc[ai][bj][m][n] = __builtin_amdgcn_mfma_f32_16x16x32_bf16(Bt_[n][1], At[m][1], acc[ai][bj][m][n], 0, 0, 0); } \
            else { _Pragma("unroll") for (int k = 0; k < 2; ++k) acc[ai][bj][m][n] = __builtin_amdgcn_mfma_f32_16x16x32_bf16(Bt_[n][k], At[m][k], acc[ai][bj][m][n], 0, 0, 0); } } } \
        __builtin_amdgcn_s_setprio(0); } while (0)
#define PG8_WAIT_V(n) asm volatile("s_waitcnt vmcnt(" #n ")" ::: "memory")
#define PG8_WAIT_L(n) asm volatile("s_waitcnt lgkmcnt(" #n ")" ::: "memory")
#define PG8_BAR __builtin_amdgcn_s_barrier()
#define PG8_SCHED __builtin_amdgcn_sched_barrier(0)
#define PG8_GLOAD(vo, ui_) do { if constexpr (GATHER) { _Pragma("unroll") for (int _h = 0; _h < 2; ++_h) _Pragma("unroll") for (int _i = 0; _i < 2; ++_i) (vo)[_h][_i] = gtab[(ui_) * 256 + _h * 128 + RA[_i]] + voffA[_i]; } } while (0)
    Unit cur, nxt; int ui = 0;
    if (!S.next(0, cur)) return;
    int sc1 = 0x7f7f7f7f; asm volatile("" : "+v"(sc1));
    f32x4 acc[2][2][4][2];
    bf16x8 At[4][2], B0[2][2], B1[2][2];
    unsigned cvo[2][2], nvo[2][2];
    PG8_GLOAD(cvo, 0);
#pragma unroll
    for (int _h = 0; _h < 2; ++_h)
#pragma unroll
        for (int _i = 0; _i < 2; ++_i) nvo[_h][_i] = GATHER ? cvo[_h][_i] : 0u;
    const char* cA = GATHER ? (const char*)A : (const char*)A + (size_t)cur.pm * tstep; const char* cB = (const char*)Bt + (size_t)cur.pn * tstep;
    if constexpr (GATHER) { LDS_WAIT(); }
    if constexpr (SP2) {
        PG8_STAGE(PG8_SB(0, 0), cB + PG8_KO(0), voffB); PG8_STAGE(PG8_SB(0, 1), cB + hstep + PG8_KO(0), voffB); PG8_STAGE_A(PG8_SA(0, 0), cA + PG8_KO(0), 0, cvo); PG8_STAGE_A(PG8_SA(0, 1), cA + PG8_KO(0), 1, cvo);
        if (wr == 1) PG8_BAR;
        PG8_WAIT_V(2); PG8_BAR;
        PG8_STAGE(PG8_SB(1, 0), cB + PG8_KO(1), voffB); PG8_STAGE_A(PG8_SA(1, 0), cA + PG8_KO(1), 0, cvo); PG8_STAGE(PG8_SB(1, 1), cB + hstep + PG8_KO(1), voffB);
        PG8_WAIT_V(6); PG8_BAR;
    } else {
        PG8_STAGE(PG8_SB(0, 0), cB + PG8_KO(0), voffB); PG8_STAGE_A(PG8_SA(0, 0), cA + PG8_KO(0), 0, cvo); PG8_STAGE(PG8_SB(0, 1), cB + hstep + PG8_KO(0), voffB); PG8_STAGE_A(PG8_SA(0, 1), cA + PG8_KO(0), 1, cvo);
        if (wr == 1) PG8_BAR;
        PG8_WAIT_V(4); PG8_BAR;
        PG8_STAGE(PG8_SB(1, 0), cB + PG8_KO(1), voffB); PG8_STAGE_A(PG8_SA(1, 0), cA + PG8_KO(1), 0, cvo); PG8_STAGE(PG8_SB(1, 1), cB + hstep + PG8_KO(1), voffB);
        PG8_WAIT_V(6); PG8_BAR;
    }
    for (;;) {
        const bool has_next = S.next(ui + 1, nxt);
        const char* nA = GATHER ? (const char*)A : (has_next ? (const char*)A + (size_t)nxt.pm * tstep : cA); const char* nB = has_next ? (const char*)Bt + (size_t)nxt.pn * tstep : cB;
        if constexpr (GATHER) { if (has_next) { PG8_GLOAD(nvo, ui + 1); } }
#define PG8_TRIP(t, Z) do { \
            const bool last = (t == nt - 2); \
            const char* a1 = cA + PG8_KO(t + 1); \
            const char* a2 = (last ? nA : cA) + PG8_KO(t + 2); const char* b2 = (last ? nB : cB) + PG8_KO(t + 2);     \
            const char* a3 = a2 + kstep; const char* b3 = b2 + kstep; \
            unsigned xvo[2][2];     \
_Pragma("unroll") \
            for (int _h = 0; _h < 2; ++_h) \
_Pragma("unroll") \
                for (int _i = 0; _i < 2; ++_i) xvo[_h][_i] = GATHER ? (last ? nvo[_h][_i] : cvo[_h][_i]) : 0u; \
            if constexpr (SP2) { \
            PG8_LDB(B0, 0, 0); PG8_LDB(B1, 0, 1); PG8_SCHED; PG8_LDA(At, 0, 0); PG8_STAGE_A(PG8_SA(1, 1), a1, 1, cvo); \
            PG8_WAIT_V(8); PG8_WAIT_L(0); PG8_BAR; PG8_MMA(0, 0, At, B0, Z); PG8_MMA(0, 1, At, B1, Z); PG8_BAR; PG8_SCHED; \
            PG8_LDA(At, 0, 1); PG8_STAGE(PG8_SB(0, 0), b2, voffB); PG8_STAGE(PG8_SB(0, 1), b2 + hstep, voffB); PG8_STAGE_A(PG8_SA(0, 0), a2, 0, xvo); \
            PG8_WAIT_V(8); PG8_WAIT_L(0); PG8_BAR; PG8_MMA(1, 0, At, B0, Z); PG8_MMA(1, 1, At, B1, Z); PG8_BAR; PG8_SCHED; \
            PG8_LDB(B0, 1, 0); PG8_LDB(B1, 1, 1); PG8_SCHED; PG8_LDA(At, 1, 0); PG8_STAGE_A(PG8_SA(0, 1), a2, 1, xvo); \
            PG8_WAIT_V(8); PG8_WAIT_L(0); PG8_BAR; PG8_MMA(0, 0, At, B0, false); PG8_MMA(0, 1, At, B1, false); PG8_BAR; PG8_SCHED; \
            PG8_LDA(At, 1, 1); PG8_STAGE(PG8_SB(1, 0), b3, voffB); PG8_STAGE(PG8_SB(1, 1), b3 + hstep, voffB); PG8_STAGE_A(PG8_SA(1, 0), a3, 0, xvo); \
            PG8_WAIT_V(8); PG8_WAIT_L(0); PG8_BAR; PG8_MMA(1, 0, At, B0, false); PG8_MMA(1, 1, At, B1, false); PG8_BAR; PG8_SCHED; \
            } else { \
            PG8_LDB(B0, 0, 0); PG8_SCHED; PG8_LDA(At, 0, 0); PG8_STAGE_A(PG8_SA(1, 1), a1, 1, cvo); \
            PG8_WAIT_L(8); PG8_BAR; PG8_WAIT_L(0); PG8_MMA(0, 0, At, B0, Z); PG8_BAR; PG8_SCHED; \
            PG8_LDB(B1, 0, 1); PG8_STAGE(PG8_SB(0, 0), b2, voffB); \
            PG8_BAR; PG8_WAIT_L(0); PG8_MMA(0, 1, At, B1, Z); PG8_BAR; \
            PG8_LDA(At, 0, 1); PG8_STAGE_A(PG8_SA(0, 0), a2, 0, xvo); \
            PG8_BAR; PG8_WAIT_L(0); PG8_MMA(1, 0, At, B0, Z); PG8_BAR; PG8_SCHED; \
            PG8_STAGE(PG8_SB(0, 1), b2 + hstep, voffB); \
            PG8_WAIT_V(6); PG8_BAR; PG8_MMA(1, 1, At, B1, Z); PG8_BAR; \
            PG8_LDB(B0, 1, 0); PG8_SCHED; PG8_LDA(At, 1, 0); PG8_STAGE_A(PG8_SA(0, 1), a2, 1, xvo); \
            PG8_WAIT_L(8); PG8_BAR; PG8_WAIT_L(0); PG8_MMA(0, 0, At, B0, false); PG8_BAR; PG8_SCHED; \
            PG8_LDB(B1, 1, 1); PG8_STAGE(PG8_SB(1, 0), b3, voffB); \
            PG8_BAR; PG8_WAIT_L(0); PG8_MMA(0, 1, At, B1, false); PG8_BAR; \
            PG8_LDA(At, 1, 1); PG8_STAGE_A(PG8_SA(1, 0), a3, 0, xvo); \
            PG8_BAR; PG8_WAIT_L(0); PG8_MMA(1, 0, At, B0, false); PG8_BAR; PG8_SCHED; \
            PG8_STAGE(PG8_SB(1, 1), b3 + hstep, voffB); \
            PG8_WAIT_V(6); PG8_BAR; PG8_MMA(1, 1, At, B1, false); PG8_BAR; \
            } \
        } while (0)
        PG8_TRIP(0, true);
#pragma unroll 1
        for (int t = 2; t < nt; t += 2) PG8_TRIP(t, false);
#undef PG8_TRIP
        if constexpr (ALIGN_EPI) { if (wr == 0) PG8_BAR; }
        if constexpr (FP8) { asm volatile("s_nop 15\n\ts_nop 15\n\ts_nop 15\n\ts_nop 15" ::: "memory"); }
        E(acc, cur, wr, wc, fr, fq);
        if (!has_next) break;
        cur = nxt; cA = nA; cB = nB; ++ui;
#pragma unroll
        for (int _h = 0; _h < 2; ++_h)
#pragma unroll
            for (int _i = 0; _i < 2; ++_i) cvo[_h][_i] = nvo[_h][_i];
        if constexpr (ALIGN_EPI) { if (wr == 1) PG8_BAR; }
    }
    PG8_WAIT_V(0);
    if constexpr (!ALIGN_EPI) { if (wr == 0) PG8_BAR; }
    PG8_BAR;
#undef PG8_SA
#undef PG8_SB
#undef PG8_STAGE
#undef PG8_STAGE_A
#undef PG8_LDA
#undef PG8_LDB
#undef PG8_MMA
#undef PG8_WAIT_V
#undef PG8_WAIT_L
#undef PG8_BAR
#undef PG8_SCHED
#undef PG8_GLOAD
#undef PG8_KO
}


__device__ __forceinline__ int kv_row(int r) { return r < NLAT ? (r >> 11) * KVLEN + (r & 2047) : ((r - NLAT) >> 8) * KVLEN + SEQ + ((r - NLAT) & 255); }

struct EpiAttnIn {
    bf16_t* Q; bf16_t* Kb; bf16_t* Vb; const float* gam4; const LAS float* ropeL;
    __device__ __forceinline__ void operator()(const f32x4 (&acc)[2][2][4][2], const Unit& u, int wr, int wc, int fr, int fq) const {
        const int pn = u.pn, grp = pn >= 3 ? 1 : 0, pl = pn - 3 * grp;
        const bool isq = pl < 2, isv = (pl == 2) && (wc >= 2), lat = u.pm < (NLAT / 256);
        const float* gam = gam4 + (grp * 2 + (isq ? 0 : 1)) * 64;
        f32x4 gv[2][2];
#pragma unroll
        for (int bj = 0; bj < 2; ++bj)
#pragma unroll
            for (int n = 0; n < 2; ++n) gv[bj][n] = *(const f32x4*)(gam + 32 * bj + 16 * n + 4 * fq);
        const float qs = isq ? C2 : 1.f;
        constexpr float ds = 1.0f / (SC_W * SC_H2);
        constexpr float EPSA = EPS / (ds * ds);
#pragma unroll
        for (int ai = 0; ai < 2; ++ai)
#pragma unroll
            for (int m = 0; m < 4; ++m) {
                const int r = u.pm * BM + ai * HALF + wr * 64 + m * 16 + fr;
                f32x4 v[2][2];
                if (ai == 0 && m == 0) __builtin_amdgcn_s_waitcnt(0x0F70);
                if (!isv) {
                    const f32x4 s4 = (acc[ai][0][m][0] * acc[ai][0][m][0] + acc[ai][0][m][1] * acc[ai][0][m][1]) + (acc[ai][1][m][0] * acc[ai][1][m][0] + acc[ai][1][m][1] * acc[ai][1][m][1]);
                    float ss = (s4[0] + s4[1]) + (s4[2] + s4[3]);
                    ss += __shfl_xor(ss, 16); ss += __shfl_xor(ss, 32);
                    const float rs = __builtin_amdgcn_rsqf(ss * (1.0f / 64.0f) + EPSA) * qs;
#pragma unroll
                    for (int bj = 0; bj < 2; ++bj)
#pragma unroll
                        for (int n = 0; n < 2; ++n) v[bj][n] = acc[ai][bj][m][n] * (gv[bj][n] * rs);
                    if (lat) {
#pragma unroll
                        for (int bj = 0; bj < 2; ++bj) { const int pos = bj ? (m * 16 + fr) : ((u.pm & 7) * 4 + ai * 2 + wr);
                            const f32x4 cx = *(const LAS f32x4*)(ropeL + pos * 32 + 4 * fq), cy = *(const LAS f32x4*)(ropeL + pos * 32 + 16 + 4 * fq), a = v[bj][0], b = v[bj][1];
                            v[bj][0] = a * cx - b * cy; v[bj][1] = a * cy + b * cx; }
                    }
                } else {
#pragma unroll
                    for (int bj = 0; bj < 2; ++bj)
#pragma unroll
                        for (int n = 0; n < 2; ++n) v[bj][n] = acc[ai][bj][m][n] * ds;
                }
                bf16_t* dst;
                if (isq) dst = Q + (size_t)r * D + (grp * 8 + pl * 4 + wc) * HD;
                else if (!isv) dst = Kb + (size_t)kv_row(r) * KVP + (grp * 2 + wc) * HD;
                else dst = Vb + (size_t)kv_row(r) * KVP + (grp * 2 + wc - 2) * HD;
#pragma unroll
                for (int bj = 0; bj < 2; ++bj)
#pragma unroll
                    for (int n = 0; n < 2; ++n) { u32x2 w; w.x = cvt_pk_bf16(v[bj][n][0], v[bj][n][1]); w.y = cvt_pk_bf16(v[bj][n][2], v[bj][n][3]);
                        *(u32x2*)(dst + 32 * bj + 16 * n + 4 * fq) = w; }
            }
    }
};

#ifndef RESID_XPF
#define RESID_XPF 6
#endif
struct EpiResid {
    bf16_t* X; const float* modL; int goff; float ds;
    __device__ __forceinline__ void operator()(const f32x4 (&acc)[2][2][4][2], const Unit& u, int wr, int wc, int fr, int fq) const {
        const int b = u.pm < (NLAT / 256) ? (u.pm >> 3) : 16;
        const float* g = modL + b * 6144 + goff;
        const int row0 = u.pm * BM + wr * 64 + fr, col0 = u.pn * BM + wc * 32 + 8 * fq;
        f32x4 gv[2][2];
#pragma unroll
        for (int bj = 0; bj < 2; ++bj)
#pragma unroll
            for (int n = 0; n < 2; ++n) gv[bj][n] = *(const f32x4*)(g + col0 + bj * HALF + 4 * n) * ds;
        constexpr int XPF = RESID_XPF;
        u32x4 xv[8][2];
#define RESID_LD(j) do { _Pragma("unroll") for (int bj = 0; bj < 2; ++bj) xv[j][bj] = *(const GAS u32x4*)(X + (size_t)(row0 + ((j) >> 2) * HALF + ((j) & 3) * 16) * D + col0 + bj * HALF); } while (0)
#pragma unroll
        for (int j = 0; j < XPF; ++j) RESID_LD(j);
#pragma unroll
        for (int j = 0; j < 8; ++j) { const int ai = j >> 2, m = j & 3; bf16_t* rowp = X + (size_t)(row0 + ai * HALF + m * 16) * D + col0;
            if (j + XPF < 8) RESID_LD(j + XPF);
            asm volatile("" ::: "memory");
#pragma unroll
            for (int bj = 0; bj < 2; ++bj) { const u32x4 x = xv[j][bj];
                const f32x4 x0 = (f32x4){bf_lo(x.x), bf_hi(x.x), bf_lo(x.y), bf_hi(x.y)}, x1 = (f32x4){bf_lo(x.z), bf_hi(x.z), bf_lo(x.w), bf_hi(x.w)};
                const f32x4 r0 = acc[ai][bj][m][0] * gv[bj][0] + x0, r1 = acc[ai][bj][m][1] * gv[bj][1] + x1;
                u32x4 w; w.x = cvt_pk_bf16(r0[0], r0[1]); w.y = cvt_pk_bf16(r0[2], r0[3]); w.z = cvt_pk_bf16(r1[0], r1[1]); w.w = cvt_pk_bf16(r1[2], r1[3]);
                *(GAS u32x4*)(rowp + bj * HALF) = w; } }
#undef RESID_LD
    }
};

struct EpiConvIn {
    bf16_t* BG; bf16_t* U;
    __device__ __forceinline__ void operator()(const f32x4 (&acc)[2][2][4][2], const Unit& u, int wr, int wc, int fr, int fq) const {
        const int row0 = u.pm * BM + wr * 64 + fr;
        if (u.pn < 4) {
            const int col0 = u.pn * BM + wc * 32 + 8 * fq;
#pragma unroll
            for (int ai = 0; ai < 2; ++ai)
#pragma unroll
                for (int m = 0; m < 4; ++m) { bf16_t* rowp = BG + (size_t)(row0 + ai * HALF + m * 16) * D + col0;
#pragma unroll
                    for (int bj = 0; bj < 2; ++bj) { const f32x4 v0 = acc[ai][bj][m][0], v1 = acc[ai][bj][m][1]; u32x4 w;
                        w.x = cvt_pk_bf16(v0[0], v0[1]); w.y = cvt_pk_bf16(v0[2], v0[3]); w.z = cvt_pk_bf16(v1[0], v1[1]); w.w = cvt_pk_bf16(v1[2], v1[3]);
                        *(u32x4*)(rowp + bj * HALF) = w; } }
        } else {
            const int col0 = (u.pn - 4) * 128 + wc * 32 + 8 * fq;
#pragma unroll
            for (int ai = 0; ai < 2; ++ai)
#pragma unroll
                for (int m = 0; m < 4; ++m) { bf16_t* rowp = U + (size_t)(row0 + ai * HALF + m * 16) * D + col0;
                    const f32x4 v0 = acc[ai][0][m][0] * acc[ai][1][m][0], v1 = acc[ai][0][m][1] * acc[ai][1][m][1]; u32x4 w;
                    w.x = cvt_pk_bf16(v0[0], v0[1]); w.y = cvt_pk_bf16(v0[2], v0[3]); w.z = cvt_pk_bf16(v1[0], v1[1]); w.w = cvt_pk_bf16(v1[2], v1[3]);
                    *(u32x4*)rowp = w; }
        }
    }
};

__device__ __forceinline__ float silu_f(float g) { return g * __builtin_amdgcn_rcpf(1.0f + __builtin_amdgcn_exp2f(-g * LOG2E)); }
struct EpiUp {
    unsigned char* HID8;
    __device__ __forceinline__ void operator()(const f32x4 (&acc)[2][2][4][2], const Unit& u, int wr, int wc, int fr, int fq) const {
        const int row0 = u.pm * BM + wr * 64 + fr, col0 = (u.pn & 7) * 128 + wc * 32 + 8 * fq;
        constexpr float ds = 1.0f / (SC_W * SC_H2);
        constexpr float c1 = -ds * LOG2E, kk = 1.0f / (ds * ds * SC_HID);
#pragma unroll
        for (int ai = 0; ai < 2; ++ai)
#pragma unroll
            for (int m = 0; m < 4; ++m) { unsigned char* rowp = HID8 + (size_t)(row0 + ai * HALF + m * 16) * D + col0;
                const f32x4 g0 = acc[ai][0][m][0], g1 = acc[ai][0][m][1], u0 = acc[ai][1][m][0], u1 = acc[ai][1][m][1];
                f32x4 t0 = g0 * c1, t1 = g1 * c1;
#pragma unroll
                for (int e = 0; e < 4; ++e) { t0[e] = __builtin_amdgcn_exp2f(t0[e]); t1[e] = __builtin_amdgcn_exp2f(t1[e]); }
                f32x4 d0 = t0 * kk + kk, d1 = t1 * kk + kk;
#pragma unroll
                for (int e = 0; e < 4; ++e) { d0[e] = __builtin_amdgcn_rcpf(d0[e]); d1[e] = __builtin_amdgcn_rcpf(d1[e]); }
                const f32x4 v0 = (g0 * u0) * d0, v1 = (g1 * u1) * d1;
                u32x2 w; w.x = pack4_fp8(v0[0], v0[1], v0[2], v0[3]); w.y = pack4_fp8(v1[0], v1[1], v1[2], v1[3]);
                *(u32x2*)rowp = w; }
    }
};
struct EpiDown {
    unsigned char* Y8; const float* gate; const float* modL;
    __device__ __forceinline__ void operator()(const f32x4 (&acc)[2][2][4][2], const Unit& u, int wr, int wc, int fr, int fq) const {
        const int b = u.pm < 256 ? (u.pm & 15) : 16;
        const float* g2 = modL + b * 6144 + 5 * 1024;
        const int row0 = u.pm * BM + wr * 64 + fr, col0 = (u.pn & 3) * BM + wc * 32 + 8 * fq;
        constexpr float ds = SC_Y / (SC_W * SC_HID);
        f32x4 gv[2][2];
#pragma unroll
        for (int bj = 0; bj < 2; ++bj)
#pragma unroll
            for (int n = 0; n < 2; ++n) gv[bj][n] = *(const f32x4*)(g2 + col0 + bj * HALF + 4 * n) * ds;
        float gts[2][4];
#pragma unroll
        for (int ai = 0; ai < 2; ++ai)
#pragma unroll
            for (int m = 0; m < 4; ++m) gts[ai][m] = ((const GAS float*)gate)[row0 + ai * HALF + m * 16];
#pragma unroll
        for (int ai = 0; ai < 2; ++ai)
#pragma unroll
            for (int m = 0; m < 4; ++m) { const int row = row0 + ai * HALF + m * 16; const float gt = gts[ai][m]; unsigned char* rowp = Y8 + (size_t)row * D + col0;
#pragma unroll
                for (int bj = 0; bj < 2; ++bj) { const f32x4 v0 = acc[ai][bj][m][0] * (gv[bj][0] * gt), v1 = acc[ai][bj][m][1] * (gv[bj][1] * gt); u32x2 w;
                    w.x = pack4_fp8(v0[0], v0[1], v0[2], v0[3]); w.y = pack4_fp8(v1[0], v1[1], v1[2], v1[3]);
                    *(u32x2*)(rowp + bj * HALF) = w; } }
    }
};
}

struct Frame {
    LAS unsigned char* lds;
    int tid, lane, wave, G;
    float* out; unsigned char* ws;
};
constexpr int PT_OFF = LDSCTL_OFF + 512;
__device__ __forceinline__ const float* inp(const Frame& F, int i) {
    const LAS unsigned* p = (const LAS unsigned*)(F.lds + PT_OFF) + 2 * i;
    const unsigned lo = (unsigned)__builtin_amdgcn_readfirstlane((int)p[0]), hi = (unsigned)__builtin_amdgcn_readfirstlane((int)p[1]);
    return (const float*)(((unsigned long long)hi << 32) | lo);
}
enum { I_X = 0, I_C, I_CTX, I_CCTX, I_ADAW, I_ADAB, I_N1G, I_N2G, I_AWIN, I_AWOUT, I_QNA, I_KNA, I_QNB, I_KNB, I_SINK, I_CWIN, I_CK, I_CB, I_CWOUT, I_RW, I_WG, I_WU, I_WD };

#define PHASE_FRAME(F0) Frame F = F0; { int t_ = threadIdx.x; asm volatile("" : "+v"(t_)); F.tid = t_; F.lane = t_ & 63; F.wave = __builtin_amdgcn_readfirstlane(t_ >> 6); }
__device__ __forceinline__ int inv32(int x) { return 16 * ((x >> 2) & 1) + 4 * (x >> 3) + (x & 3); }
enum { RM_NAT = 0, RM_AIN, RM_P8, RM_CIN, RM_UPG, RM_UPU };
__device__ __forceinline__ int row_map(int mode, int l0, int x) {
    switch (mode) {
    case RM_NAT: return l0 + x;
    case RM_AIN: return (l0 & ~255) + ((l0 >> 5) & 1) * 128 + ((l0 >> 6) & 3) * 32 + x;
    case RM_P8:  return l0 + inv32(x);
    case RM_CIN: if (l0 < 1024) return l0 + inv32(x);
                 else { const int j = (l0 - 1024) & 1023, isv = (l0 >= 2048); return 1024 + 256 * (j >> 7) + 128 * isv + 32 * ((j >> 5) & 3) + inv32(x); }
    case RM_UPG: return 256 * (l0 >> 7) + 32 * ((l0 >> 5) & 3) + inv32(x);
    default:     return 256 * (l0 >> 7) + 128 + 32 * ((l0 >> 5) & 3) + inv32(x);
    }
}
struct TItem { const float* W; bf16_t* WT; int N, mode, item; bool f8; };
__device__ __forceinline__ void titem_load(const TItem& T, int lane, f32x4 (&v)[8]) {
    const int nblk = T.N / 32, kb = T.item / nblk, nb = T.item % nblk, k0 = 64 * kb, n0 = 32 * nb;
#pragma unroll
    for (int i = 0; i < 8; ++i) v[i] = *(const GAS f32x4*)(T.W + (size_t)(k0 + 8 * i + (lane >> 3)) * T.N + n0 + 4 * (lane & 7));
}
__device__ __forceinline__ void titem_store(const TItem& T, int lane, const f32x4 (&v)[8], LAS float* scr) {
    const int nblk = T.N / 32, kb = T.item / nblk, nb = T.item % nblk, k0 = 64 * kb, n0 = 32 * nb;
#pragma unroll
    for (int i = 0; i < 8; ++i) { LAS float* s = scr + (8 * i + (lane >> 3)) * 33 + 4 * (lane & 7); s[0] = v[i][0]; s[1] = v[i][1]; s[2] = v[i][2]; s[3] = v[i][3]; }
    LDS_WAIT(); asm volatile("" ::: "memory");
    const int c = lane & 7;
#pragma unroll
    for (int j = 0; j < 4; ++j) { const int n = (lane >> 3) + 8 * j; const LAS float* s = scr + (8 * c) * 33 + n;
        if (T.f8) { u32x2 o; o.x = pg8::pack4_fp8(s[0 * 33] * pg8::SC_W, s[1 * 33] * pg8::SC_W, s[2 * 33] * pg8::SC_W, s[3 * 33] * pg8::SC_W); o.y = pg8::pack4_fp8(s[4 * 33] * pg8::SC_W, s[5 * 33] * pg8::SC_W, s[6 * 33] * pg8::SC_W, s[7 * 33] * pg8::SC_W);
            *(GAS u32x2*)((unsigned char*)T.WT + (size_t)row_map(T.mode, n0, n) * 1024 + k0 + 8 * c) = o; }
        else { u32x4 o; o.x = pk2(s[0 * 33], s[1 * 33]); o.y = pk2(s[2 * 33], s[3 * 33]); o.z = pk2(s[4 * 33], s[5 * 33]); o.w = pk2(s[6 * 33], s[7 * 33]);
            *(GAS u32x4*)(T.WT + (size_t)row_map(T.mode, n0, n) * 1024 + k0 + 8 * c) = o; } }
    LDS_WAIT(); asm volatile("" ::: "memory");
}
__device__ __forceinline__ void p0_transpose_item(const float* W, int N, bf16_t* WT, int mode, LAS float* scr, int item, int lane, bool f8 = false) {
    const TItem T{W, WT, N, mode, item, f8}; f32x4 v[8]; titem_load(T, lane, v); titem_store(T, lane, v, scr);
}
__device__ __forceinline__ TItem moe_item(Frame& F, int L, int r) {
    constexpr int I_SQ = 16 * (1024 / 32);
    const int mi = r / I_SQ, item = r % I_SQ, e = mi / 3, which = mi % 3;
    const float* W = (which == 0 ? inp(F, I_WG) : which == 1 ? inp(F, I_WU) : inp(F, I_WD)) + (size_t)(L * 16 + e) * 1024 * 1024;
    bf16_t* WT = (bf16_t*)(which < 2 ? F.ws + WS_WUP + (size_t)(L * 16 + e) * 2048 * 1024 : F.ws + WS_WDN + (size_t)(L * 16 + e) * 1024 * 1024);
    return TItem{W, WT, 1024, which == 0 ? RM_UPG : which == 1 ? RM_UPU : RM_P8, item, true};
}
__device__ __forceinline__ void moe_convert_run(Frame& F, int L, int first, int end, int stride, LAS float* scr) {
    if (first >= end) return;
    f32x4 nv[8]; TItem nT = moe_item(F, L, first); titem_load(nT, F.lane, nv);
    for (int r = first; r < end; r += stride) {
        const TItem T = nT; f32x4 v[8];
#pragma unroll
        for (int i = 0; i < 8; ++i) v[i] = nv[i];
        if (r + stride < end) { nT = moe_item(F, L, r + stride); titem_load(nT, F.lane, nv); }
        titem_store(T, F.lane, v, scr);
    }
}
__device__ __forceinline__ void moe_convert_slice(const Frame& F0, int L, int first, int n, int rank, int n_idle) {
    PHASE_FRAME(F0);
    const int per = (n + n_idle - 1) / n_idle, lo = first + rank * per, hi = (lo + per < first + n) ? lo + per : first + n;
    moe_convert_run(F, L, lo + F.wave, hi, 8, (LAS float*)(F.lds + F.wave * 16384));
}
constexpr int CV0_PRO = 12288;
__device__ __forceinline__ void p0_prologue(const Frame& F0) {
    PHASE_FRAME(F0);
    unsigned char* ws = F.ws;
    {
        LAS float* sc = (LAS float*)F.lds;
        LAS float* P = (LAS float*)(F.lds + 17 * 1024 * 4);
        { const GAS float* cp = (const GAS float*)inp(F, I_C) + F.tid; const GAS float* ccp = (const GAS float*)inp(F, I_CCTX) + F.tid;
          float cv[34];
#pragma unroll
          for (int i = 0; i < 32; ++i) cv[i] = cp[512 * i];
          cv[32] = ccp[0]; cv[33] = ccp[512];
#pragma unroll
          for (int i = 0; i < 34; ++i) sc[F.tid + 512 * i] = cv[i] / (1.0f + __expf(-cv[i])); }
        __syncthreads();
        float* mod = (float*)(ws + WS_MOD);
        for (int item = blockIdx.x; item < 256; item += F.G) {
            const int L = item >> 6, n0 = (item & 63) * 96;
            const int kg = F.tid / 24, cq = F.tid % 24;
            f32x4 acc[17];
#pragma unroll
            for (int r = 0; r < 17; ++r) acc[r] = (f32x4){0.f, 0.f, 0.f, 0.f};
            if (kg < 16) {
                const GAS float* wp = (const GAS float*)(inp(F, I_ADAW) + ((size_t)L * 1024 + kg) * 6144 + n0 + 4 * cq);
                f32x4 wa[4], wb[4];
#define MODW_LD(W, j0) do { _Pragma("unroll") for (int q = 0; q < 4; ++q) W[q] = *(const GAS f32x4*)(wp + (size_t)(((j0) + q) & 63) * 16 * 6144); } while (0)
#define MODW_USE(W, j0) do { _Pragma("unroll") for (int q = 0; q < 4; ++q) { const int k = kg + 16 * ((j0) + q); _Pragma("unroll") for (int r = 0; r < 17; ++r) acc[r] += W[q] * sc[r * 1024 + k]; asm volatile("" ::: "memory"); } } while (0)
                MODW_LD(wa, 0);
#pragma unroll 1
                for (int j = 0; j < 64; j += 8) { MODW_LD(wb, j + 4); MODW_USE(wa, j); MODW_LD(wa, j + 8); MODW_USE(wb, j + 4); }
#undef MODW_LD
#undef MODW_USE
            }
#pragma unroll
            for (int batch = 0; batch < 2; ++batch) {
                const int r0 = batch * 9, nr = batch ? 8 : 9;
                if (kg < 16) {
#pragma unroll
                    for (int r = 0; r < 9; ++r) if (r0 + r < 17) *(LAS f32x4*)(P + kg * 864 + r * 96 + 4 * cq) = acc[r0 + r < 17 ? r0 + r : 0];
                }
                __syncthreads();
                for (int o = F.tid; o < nr * 96; o += 512) { float s = 0.f;
#pragma unroll
                    for (int g = 0; g < 16; ++g) s += P[g * 864 + o];
                    const int r = r0 + o / 96, n = n0 + o % 96; mod[((size_t)L * 17 + r) * 6144 + n] = s + inp(F, I_ADAB)[L * 6144 + n]; }
                __syncthreads();
            }
        }
    }
    if (blockIdx.x == (unsigned)(F.G - 1)) {
        float* ropef = (float*)(ws + WS_ROPE);
        for (int idx = F.tid; idx < 1024; idx += 512) {
            const int pos = idx >> 4, i = idx & 15;
            double f = 1.0; for (int q = 0; q < i; ++q) f *= 0.56234132519034908;
            double a = (double)pos * f; const double TWO_PI = 6.283185307179586476925;
            a -= TWO_PI * __builtin_floor(a * (1.0 / TWO_PI) + 0.5);
            double cs = 1.0, sn = a, tc = 1.0, tsn = a; const double a2 = a * a;
#pragma unroll
            for (int q = 1; q < 24; ++q) { tc *= a2 * (-1.0 / (double)((2 * q - 1) * (2 * q))); tsn *= a2 * (-1.0 / (double)((2 * q) * (2 * q + 1))); cs += tc; sn += tsn; }
            ropef[pos * 32 + i] = (float)cs; ropef[pos * 32 + 16 + i] = (float)sn;
        }
        { float* gam = (float*)(ws + WS_GAM); const int jl = F.tid >> 8, w = (F.tid >> 6) & 3, d = F.tid & 63;
          const float* src = w == 0 ? inp(F, I_QNA) : w == 1 ? inp(F, I_KNA) : w == 2 ? inp(F, I_QNB) : inp(F, I_KNB); gam[F.tid] = src[jl * 64 + d]; }
    }
    {
        LAS float* scr = (LAS float*)(F.lds + F.wave * 16384);
        const int gw = blockIdx.x * 8 + F.wave, NGW = F.G * 8;
        constexpr int I_AIN = 16 * (1536 / 32), I_SQ = 16 * (1024 / 32), I_CIN = 16 * (3072 / 32);
        constexpr int NSMALL = 2 * (I_AIN + I_SQ + I_CIN + I_SQ), NITEMS = NSMALL + 48 * I_SQ;
        for (int it = gw; it < NITEMS; it += NGW) {
            if (it >= NSMALL) break;
            int r = it; const int j = r >= NSMALL / 2 ? 1 : 0; r -= j * (NSMALL / 2);
            if (r < I_AIN) { p0_transpose_item(inp(F, I_AWIN) + (size_t)j * 1024 * 1536, 1536, (bf16_t*)(ws + WS_WAIN + (size_t)j * 1536 * 1024), RM_AIN, scr, r, F.lane, true); continue; } r -= I_AIN;
            if (r < I_SQ) { p0_transpose_item(inp(F, I_AWOUT) + (size_t)j * 1024 * 1024, 1024, (bf16_t*)(ws + WS_WAOUT + (size_t)j * 1024 * 1024), RM_P8, scr, r, F.lane, true); continue; } r -= I_SQ;
            if (r < I_CIN) { p0_transpose_item(inp(F, I_CWIN) + (size_t)j * 1024 * 3072, 3072, (bf16_t*)(ws + WS_WCIN) + (size_t)j * 3072 * 1024, RM_CIN, scr, r, F.lane); continue; } r -= I_CIN;
            p0_transpose_item(inp(F, I_CWOUT) + (size_t)j * 1024 * 1024, 1024, (bf16_t*)(ws + WS_WCOUT) + (size_t)j * 1024 * 1024, RM_P8, scr, r, F.lane);
        }
        moe_convert_run(F, 0, gw, CV0_PRO, NGW, scr);
    }
}

__device__ __forceinline__ bf16_t* x_row_ptr(Frame& F, int row) { return (bf16_t*)(F.ws + WS_X) + (size_t)row * D; }
struct RowReq { u32x2 x[4]; unsigned w[4][4]; unsigned long long rest; unsigned ts; int row; unsigned vm; };
__device__ __forceinline__ const GAS unsigned* y_row_ptr(Frame& F, int row, int e, unsigned slot) {
    const bool lat = row < NLAT; const int b = lat ? (row >> 11) : ((row - NLAT) >> 8);
    const int T = lat ? e * 16 + b : 256 + e * 2 + (b >> 3);
    return (const GAS unsigned*)(F.ws + WS_Y + ((size_t)T * 256 + slot) * D) + F.lane;
}
__device__ __forceinline__ void y_add4(f32x4& v, unsigned w) {
    constexpr float r = 1.0f / pg8::SC_Y;
    v[0] += __builtin_amdgcn_cvt_f32_fp8((int)w, 0) * r; v[1] += __builtin_amdgcn_cvt_f32_fp8((int)w, 1) * r; v[2] += __builtin_amdgcn_cvt_f32_fp8((int)w, 2) * r; v[3] += __builtin_amdgcn_cvt_f32_fp8((int)w, 3) * r;
}
__device__ __forceinline__ void row_issue(Frame& F, RowReq& R, int row, unsigned ts) {
    R.row = row; R.ts = ts;
    const GAS u32x2* xr = (const GAS u32x2*)x_row_ptr(F, row) + F.lane;
#pragma unroll
    for (int j = 0; j < 4; ++j) R.x[j] = xr[64 * j];
    unsigned long long mask = __ballot(ts != 0xFFFFu);
    unsigned vm = 0u;
#pragma unroll
    for (int k = 0; k < 4; ++k) {
        const bool has = mask != 0ull;
        const int e = has ? __builtin_ctzll(mask) : 0;
        const unsigned sl = (unsigned)__builtin_amdgcn_readlane((int)ts, e);
        mask &= mask - 1ull;
        const GAS unsigned* y = y_row_ptr(F, row, has ? e : 0, has ? sl : 0u);
#pragma unroll
        for (int j = 0; j < 4; ++j) R.w[k][j] = y[64 * j];
        vm |= has ? (1u << k) : 0u;
    }
    R.vm = vm; R.rest = mask;
}
__device__ __forceinline__ void row_consume(Frame& F, const RowReq& R, f32x4 (&v)[4]) {
#pragma unroll
    for (int j = 0; j < 4; ++j) v[j] = (f32x4){bf_lo(R.x[j].x), bf_hi(R.x[j].x), bf_lo(R.x[j].y), bf_hi(R.x[j].y)};
#pragma unroll
    for (int k = 0; k < 4; ++k)
        if ((R.vm >> k) & 1u) {
#pragma unroll
            for (int j = 0; j < 4; ++j) y_add4(v[j], R.w[k][j]); }
    unsigned long long mask = R.rest;
    while (mask) {
        const int e = __builtin_ctzll(mask); mask &= mask - 1;
        const GAS unsigned* y = y_row_ptr(F, R.row, e, (unsigned)__builtin_amdgcn_readlane((int)R.ts, e));
#pragma unroll
        for (int j = 0; j < 4; ++j) { const unsigned ww = y[64 * j]; y_add4(v[j], ww); }
    }
}
struct RowRq { u32x4 x[2]; u32x4 w[8]; unsigned long long rest; unsigned ts; int row; unsigned vm; };
__device__ __forceinline__ const GAS u32x4* y_row_ptr16(Frame& F, int row, int e, unsigned slot) {
    const bool lat = row < NLAT; const int b = lat ? (row >> 11) : ((row - NLAT) >> 8);
    const int T = lat ? e * 16 + b : 256 + e * 2 + (b >> 3);
    return (const GAS u32x4*)(F.ws + WS_Y + ((size_t)T * 256 + slot) * D) + F.lane;
}
__device__ __forceinline__ void rowrq_issue(Frame& F, RowRq& R, int row, unsigned ts) {
    R.row = row; R.ts = ts;
    const GAS u32x4* xr = (const GAS u32x4*)x_row_ptr(F, row) + 2 * F.lane;
    R.x[0] = xr[0]; R.x[1] = xr[1];
    unsigned long long mask = __ballot(ts != 0xFFFFu);
    unsigned vm = 0u;
#pragma unroll
    for (int k = 0; k < 8; ++k) {
        const bool has = mask != 0ull;
        const int e = has ? __builtin_ctzll(mask) : 0;
        const unsigned sl = (unsigned)__builtin_amdgcn_readlane((int)ts, e);
        mask &= mask - 1ull;
        R.w[k] = *y_row_ptr16(F, row, has ? e : 0, has ? sl : 0u);
        vm |= has ? (1u << k) : 0u;
    }
    R.vm = vm; R.rest = mask;
}
__device__ __forceinline__ void rowrq_consume(Frame& F, const RowRq& R, f32x4 (&v)[4]) {
#pragma unroll
    for (int h = 0; h < 2; ++h) { const u32x4 x = R.x[h]; v[2 * h] = (f32x4){bf_lo(x.x), bf_hi(x.x), bf_lo(x.y), bf_hi(x.y)}; v[2 * h + 1] = (f32x4){bf_lo(x.z), bf_hi(x.z), bf_lo(x.w), bf_hi(x.w)}; }
#pragma unroll
    for (int k = 0; k < 8; ++k)
        if ((R.vm >> k) & 1u) {
#pragma unroll
            for (int q = 0; q < 4; ++q) y_add4(v[q], R.w[k][q]); }
    unsigned long long mask = R.rest;
    while (mask) {
        const int e = __builtin_ctzll(mask); mask &= mask - 1;
        const u32x4 ww = *y_row_ptr16(F, R.row, e, (unsigned)__builtin_amdgcn_readlane((int)R.ts, e));
#pragma unroll
        for (int q = 0; q < 4; ++q) y_add4(v[q], ww[q]);
    }
}
__device__ __forceinline__ void tokslot_preload(Frame& F, LAS unsigned short* strip, int rbeg, int nk) {
    const unsigned short* tokslot = (const unsigned short*)(F.ws + WS_TOKSLOT);
    if (F.lane < 16) {
        unsigned short t[18];
#pragma unroll
        for (int k = 0; k < 18; ++k) t[k] = k < nk ? tokslot[(size_t)F.lane * NROWS + rbeg + k] : (unsigned short)0xFFFFu;
#pragma unroll
        for (int k = 0; k < 18; ++k) strip[k * 16 + F.lane] = t[k];
    }
    LDS_WAIT(); asm volatile("" ::: "memory");
}
__device__ __forceinline__ void x_load_row(const bf16_t* xr, int lane, f32x4 (&v)[4]) {
#pragma unroll
    for (int j = 0; j < 4; ++j) { const u32x2 w = ((const GAS u32x2*)xr)[lane + 64 * j]; v[j] = (f32x4){bf_lo(w.x), bf_hi(w.x), bf_lo(w.y), bf_hi(w.y)}; }
}
__device__ __forceinline__ void x_store_row(bf16_t* xr, int lane, const f32x4 (&v)[4]) {
#pragma unroll
    for (int j = 0; j < 4; ++j) { u32x2 w; w.x = pk2(v[j][0], v[j][1]); w.y = pk2(v[j][2], v[j][3]); ((GAS u32x2*)xr)[lane + 64 * j] = w; }
}

__device__ __forceinline__ void n1_finish(Frame& F, int L, int row, const f32x4 (&v)[4], const f32x4 (&gs)[4], const f32x4 (&sh)[4]) {
    bf16_t* H = (bf16_t*)(F.ws + WS_H);
    x_store_row(x_row_ptr(F, row), F.lane, v);
    float ss = 0.f;
#pragma unroll
    for (int j = 0; j < 4; ++j) ss += (v[j][0] * v[j][0] + v[j][1] * v[j][1]) + (v[j][2] * v[j][2] + v[j][3] * v[j][3]);
    const float rinv = __builtin_amdgcn_rsqf(wave_sum(ss) * (1.0f / D) + EPS);
    if ((L & 1) == 0) {
        GAS unsigned* o4 = (GAS unsigned*)((unsigned char*)H + (size_t)row * D) + F.lane;
#pragma unroll
        for (int j = 0; j < 4; ++j) { const f32x4 h = ((v[j] * rinv) * gs[j] + sh[j]) * pg8::SC_H2; o4[64 * j] = pg8::pack4_fp8(h[0], h[1], h[2], h[3]); }
    } else {
        GAS u32x2* o8 = (GAS u32x2*)(H + (size_t)row * D) + F.lane;
#pragma unroll
        for (int j = 0; j < 4; ++j) { const f32x4 h = (v[j] * rinv) * gs[j] + sh[j]; u32x2 w; w.x = pk2(h[0], h[1]); w.y = pk2(h[2], h[3]); o8[64 * j] = w; }
    }
}
__device__ __forceinline__ void n1_finish16(Frame& F, int L, int row, const f32x4 (&v)[4], const f32x4 (&gs)[4], const f32x4 (&sh)[4]) {
    { GAS u32x4* xo = (GAS u32x4*)x_row_ptr(F, row) + 2 * F.lane;
#pragma unroll
      for (int h = 0; h < 2; ++h) { u32x4 w; w.x = pk2(v[2 * h][0], v[2 * h][1]); w.y = pk2(v[2 * h][2], v[2 * h][3]); w.z = pk2(v[2 * h + 1][0], v[2 * h + 1][1]); w.w = pk2(v[2 * h + 1][2], v[2 * h + 1][3]); xo[h] = w; } }
    float ss = 0.f;
#pragma unroll
    for (int j = 0; j < 4; ++j) ss += (v[j][0] * v[j][0] + v[j][1] * v[j][1]) + (v[j][2] * v[j][2] + v[j][3] * v[j][3]);
    const float rinv = __builtin_amdgcn_rsqf(wave_sum(ss) * (1.0f / D) + EPS);
    if ((L & 1) == 0) {
        u32x4 o;
#pragma unroll
        for (int q = 0; q < 4; ++q) { const f32x4 h = ((v[q] * rinv) * gs[q] + sh[q]) * pg8::SC_H2; o[q] = pg8::pack4_fp8(h[0], h[1], h[2], h[3]); }
        *((GAS u32x4*)((unsigned char*)(F.ws + WS_H) + (size_t)row * D) + F.lane) = o;
    } else {
        GAS u32x4* ho = (GAS u32x4*)((bf16_t*)(F.ws + WS_H) + (size_t)row * D) + 2 * F.lane;
#pragma unroll
        for (int hh = 0; hh < 2; ++hh) { const f32x4 h0 = (v[2 * hh] * rinv) * gs[2 * hh] + sh[2 * hh], h1 = (v[2 * hh + 1] * rinv) * gs[2 * hh + 1] + sh[2 * hh + 1];
            u32x4 w; w.x = pk2(h0[0], h0[1]); w.y = pk2(h0[2], h0[3]); w.z = pk2(h1[0], h1[1]); w.w = pk2(h1[2], h1[3]); ho[hh] = w; }
    }
}
__device__ __forceinline__ void n1_phase(const Frame& F0, int L, int nrows) {
    PHASE_FRAME(F0);
    const int gw = blockIdx.x * 8 + F.wave, NGW = F.G * 8, RPW = nrows / NGW, rbeg = gw * RPW;
    const float* gn = inp(F, I_N1G) + L * 1024; const float* modL = (const float*)(F.ws + WS_MOD) + (size_t)L * 17 * 6144;
    LAS unsigned short* strip = (LAS unsigned short*)F.lds + F.wave * 512;
    f32x4 gs[4], sh[4]; int bcur = -1;
#define N1_MOD(row) do { const int bm_ = (row) < NLAT ? ((row) >> 11) : 16; \
        if (bm_ != bcur) { bcur = bm_; const float* mrow = modL + bm_ * 6144;     \
            _Pragma("unroll") for (int j = 0; j < 4; ++j) { const int c = 4 * F.lane + 256 * j; gs[j] = *(const f32x4*)(gn + c) * (*(const f32x4*)(mrow + 1024 + c) + 1.0f); sh[j] = *(const f32x4*)(mrow + c); } } } while (0)
    if (L == 0) {
#define N1_XIN(r) ((r) < NLAT ? inp(F, I_X) + (size_t)(r) * D : inp(F, I_CTX) + (size_t)((r) - NLAT) * D)
#define N1_XLD(X, r) do { const GAS f32x4* xin_ = (const GAS f32x4*)N1_XIN(r) + F.lane; _Pragma("unroll") for (int j = 0; j < 4; ++j) X[j] = xin_[64 * j]; } while (0)
#define N1_STEP0(XC, XI, kk) do { const int k_ = (kk), row_ = rbeg + k_; N1_MOD(row_); N1_XLD(XI, rbeg + (k_ + 2 < RPW ? k_ + 2 : RPW - 1)); n1_finish(F, L, row_, XC, gs, sh); } while (0)
        f32x4 X0[4], X1[4], X2[4];
        N1_XLD(X0, rbeg); N1_XLD(X1, rbeg + 1);
        int k = 0;
        for (; k + 2 < RPW; k += 3) { N1_STEP0(X0, X2, k); N1_STEP0(X1, X0, k + 1); N1_STEP0(X2, X1, k + 2); }
        if (k < RPW) { N1_STEP0(X0, X2, k); if (k + 1 < RPW) N1_STEP0(X1, X0, k + 1); }
#undef N1_STEP0
#undef N1_XLD
#undef N1_XIN
    } else {
        tokslot_preload(F, strip, rbeg, RPW);
#define N1_MOD16(row) do { const int bm_ = (row) < NLAT ? ((row) >> 11) : 16; \
        if (bm_ != bcur) { bcur = bm_; const float* mrow = modL + bm_ * 6144;     \
            _Pragma("unroll") for (int q = 0; q < 4; ++q) { const int c = 16 * F.lane + 4 * q; gs[q] = *(const f32x4*)(gn + c) * (*(const f32x4*)(mrow + 1024 + c) + 1.0f); sh[q] = *(const f32x4*)(mrow + c); } } } while (0)
#define N1_ISSUE(R, kk) do { const int kn_ = (kk) < RPW ? (kk) : RPW - 1; rowrq_issue(F, R, rbeg + kn_, F.lane < 16 ? (unsigned)strip[kn_ * 16 + F.lane] : 0xFFFFu); } while (0)
#define N1_STEP(RC, RI, kk) do { const int k_ = (kk), row_ = rbeg + k_; N1_MOD16(row_); N1_ISSUE(RI, k_ + 2); f32x4 v_[4]; rowrq_consume(F, RC, v_); n1_finish16(F, L, row_, v_, gs, sh); } while (0)
        RowRq R0, R1, R2;
        N1_ISSUE(R0, 0); N1_ISSUE(R1, 1);
        int k = 0;
        for (; k + 2 < RPW; k += 3) { N1_STEP(R0, R2, k); N1_STEP(R1, R0, k + 1); N1_STEP(R2, R1, k + 2); }
        if (k < RPW) { N1_STEP(R0, R2, k); if (k + 1 < RPW) N1_STEP(R1, R0, k + 1); }
#undef N1_STEP
#undef N1_MOD16
#undef N1_ISSUE
    }
#undef N1_MOD
}
__device__ __forceinline__ void fin_phase(const Frame& F0) {
    PHASE_FRAME(F0);
    const int gw = blockIdx.x * 8 + F.wave, NGW = F.G * 8, RPW = NLAT / NGW, rbeg = gw * RPW;
    LAS unsigned short* strip = (LAS unsigned short*)F.lds + F.wave * 512;
    tokslot_preload(F, strip, rbeg, RPW);
    LAS unsigned char* stg = F.lds + 16384 + F.wave * 5120;
#define FIN_ISSUE(R, kk) do { const int kn_ = (kk) < RPW ? (kk) : RPW - 1; rowrq_issue(F, R, rbeg + kn_, F.lane < 16 ? (unsigned)strip[kn_ * 16 + F.lane] : 0xFFFFu); } while (0)
#define FIN_STEP(RC, RI, kk) do { const int k_ = (kk), row_ = rbeg + k_; FIN_ISSUE(RI, k_ + 2); f32x4 v_[4]; rowrq_consume(F, RC, v_); float* orow = F.out + (size_t)row_ * D; \
        _Pragma("unroll") for (int q = 0; q < 4; ++q) *(LAS f32x4*)(stg + F.lane * 80 + 16 * q) = v_[q]; \
        LDS_WAIT(); asm volatile("" ::: "memory"); \
        _Pragma("unroll") for (int j = 0; j < 4; ++j) { const int cq = F.lane + 64 * j; ((GAS f32x4*)orow)[cq] = *(const LAS f32x4*)(stg + (cq >> 2) * 80 + (cq & 3) * 16); } \
        asm volatile("" ::: "memory"); } while (0)
    RowRq R0, R1, R2;
    FIN_ISSUE(R0, 0); FIN_ISSUE(R1, 1);
    int k = 0;
    for (; k + 2 < RPW; k += 3) { FIN_STEP(R0, R2, k); FIN_STEP(R1, R0, k + 1); FIN_STEP(R2, R1, k + 2); }
    if (k < RPW) { FIN_STEP(R0, R2, k); if (k + 1 < RPW) FIN_STEP(R1, R0, k + 1); }
#undef FIN_STEP
#undef FIN_ISSUE
}
__device__ __forceinline__ void n2_phase(const Frame& F0, int L, int nrows) {
    PHASE_FRAME(F0);
    LAS unsigned short* WH = (LAS unsigned short*)F.lds;
    LAS unsigned short* WL = WH + 16384;
    LAS float* PSS = (LAS float*)(F.lds + 65536);
    LAS float* PLG = (LAS float*)(F.lds + 65536 + 1024);
    { const GAS float* rw = (const GAS float*)(inp(F, I_RW) + (size_t)L * 1024 * 16) + F.tid;
      float wv[32];
#pragma unroll
      for (int i = 0; i < 32; ++i) wv[i] = rw[512 * i];
#pragma unroll
      for (int i = 0; i < 32; ++i) { const int idx = F.tid + 512 * i, k = idx >> 4, e = idx & 15; const float w = wv[i];
          const unsigned hi = pk2(w, 0.f) & 0xffffu; const float rem = w - bf_lo(hi); const int o = ((k >> 3) * 16 + e) * 8 + (k & 7);
          WH[o] = (unsigned short)hi; WL[o] = (unsigned short)(pk2(rem, 0.f) & 0xffffu); } }
    __syncthreads();
    const float* gn = inp(F, I_N2G) + L * 1024; const float* modL = (const float*)(F.ws + WS_MOD) + (size_t)L * 17 * 6144;
    unsigned char* H8 = F.ws + WS_H; float* AFF = (float*)(F.ws + WS_AFF); const bf16_t* X = (const bf16_t*)(F.ws + WS_X);
    const int RPB = nrows / F.G, NG = RPB / 16, rb = (int)blockIdx.x * RPB;
    const int r = F.lane & 15, kg = F.lane >> 4, c0 = 128 * F.wave + 8 * kg;
    u32x4 nraw[4];
#pragma unroll
    for (int s_ = 0; s_ < 4; ++s_) nraw[s_] = *(const GAS u32x4*)(X + (size_t)(rb + r) * D + c0 + 32 * s_);
    f32x4 gs[4][2], sh[4][2];
    for (int g = 0; g < NG;) {
      int gend = NG;
      { const int row0_ = rb + 16 * g, bm = row0_ < NLAT ? (row0_ >> 11) : 16; const float* mrow = modL + bm * 6144;
        if (row0_ < NLAT) { const int ge = ((((row0_ >> 11) + 1) << 11) - rb) >> 4; gend = ge < NG ? ge : NG; }
#pragma unroll
        for (int s_ = 0; s_ < 4; ++s_)
#pragma unroll
            for (int q = 0; q < 2; ++q) { const int c = c0 + 32 * s_ + 4 * q; gs[s_][q] = *(const GAS f32x4*)(gn + c) * (*(const GAS f32x4*)(mrow + 4 * 1024 + c) + 1.0f); sh[s_][q] = *(const GAS f32x4*)(mrow + 3 * 1024 + c); } }
      for (; g < gend; ++g) {
        const int row0 = rb + 16 * g, row = row0 + r, par = g & 1;
        f32x4 v[4][2];
#pragma unroll
        for (int s_ = 0; s_ < 4; ++s_) { v[s_][0] = (f32x4){bf_lo(nraw[s_].x), bf_hi(nraw[s_].x), bf_lo(nraw[s_].y), bf_hi(nraw[s_].y)}; v[s_][1] = (f32x4){bf_lo(nraw[s_].z), bf_hi(nraw[s_].z), bf_lo(nraw[s_].w), bf_hi(nraw[s_].w)}; }
        if (g + 1 < NG) {
#pragma unroll
            for (int s_ = 0; s_ < 4; ++s_) nraw[s_] = *(const GAS u32x4*)(X + (size_t)(row + 16) * D + c0 + 32 * s_);
        }
        float ss = 0.f;
#pragma unroll
        for (int s_ = 0; s_ < 4; ++s_)
#pragma unroll
            for (int q = 0; q < 2; ++q) ss += (v[s_][q][0] * v[s_][q][0] + v[s_][q][1] * v[s_][q][1]) + (v[s_][q][2] * v[s_][q][2] + v[s_][q][3] * v[s_][q][3]);
        ss += __shfl_xor(ss, 16); ss += __shfl_xor(ss, 32);
        if (kg == 0) PSS[(par * 8 + F.wave) * 16 + r] = ss;
        __syncthreads();
        float tot = 0.f;
#pragma unroll
        for (int w = 0; w < 8; ++w) tot += PSS[(par * 8 + w) * 16 + r];
        const float rinv = __builtin_amdgcn_rsqf(tot * (1.0f / D) + EPS);
        u32x4 ahi[4], alo[4];
#pragma unroll
        for (int s_ = 0; s_ < 4; ++s_) {
            const f32x4 h0 = (v[s_][0] * rinv) * gs[s_][0] + sh[s_][0], h1 = (v[s_][1] * rinv) * gs[s_][1] + sh[s_][1];
            u32x4 hi; hi.x = pk2(h0[0], h0[1]); hi.y = pk2(h0[2], h0[3]); hi.z = pk2(h1[0], h1[1]); hi.w = pk2(h1[2], h1[3]);
            { u32x2 h8; h8.x = pg8::pack4_fp8(h0[0] * pg8::SC_H2, h0[1] * pg8::SC_H2, h0[2] * pg8::SC_H2, h0[3] * pg8::SC_H2); h8.y = pg8::pack4_fp8(h1[0] * pg8::SC_H2, h1[1] * pg8::SC_H2, h1[2] * pg8::SC_H2, h1[3] * pg8::SC_H2);
              *(GAS u32x2*)(H8 + (size_t)row * D + c0 + 32 * s_) = h8; } ahi[s_] = hi;
            alo[s_].x = pk2(h0[0] - bf_lo(hi.x), h0[1] - bf_hi(hi.x)); alo[s_].y = pk2(h0[2] - bf_lo(hi.y), h0[3] - bf_hi(hi.y));
            alo[s_].z = pk2(h1[0] - bf_lo(hi.z), h1[1] - bf_hi(hi.z)); alo[s_].w = pk2(h1[2] - bf_lo(hi.w), h1[3] - bf_hi(hi.w)); }
        f32x4 acc = (f32x4){0.f, 0.f, 0.f, 0.f};
#pragma unroll
        for (int s_ = 0; s_ < 4; ++s_) { const int o = ((16 * F.wave + 4 * s_ + kg) * 16 + r) * 8;
            const bf16x8 bh = *(const LAS bf16x8*)(WH + o), bl = *(const LAS bf16x8*)(WL + o);
            const bf16x8 ah = __builtin_bit_cast(bf16x8, ahi[s_]), al = __builtin_bit_cast(bf16x8, alo[s_]);
            acc = __builtin_amdgcn_mfma_f32_16x16x32_bf16(ah, bh, acc, 0, 0, 0);
            acc = __builtin_amdgcn_mfma_f32_16x16x32_bf16(ah, bl, acc, 0, 0, 0);
            acc = __builtin_amdgcn_mfma_f32_16x16x32_bf16(al, bh, acc, 0, 0, 0); }
#pragma unroll
        for (int i = 0; i < 4; ++i) PLG[((par * 8 + F.wave) * 16 + 4 * kg + i) * 16 + r] = acc[i];
        __syncthreads();
        if (F.lane < 32) { const int rl = 2 * F.wave + (F.lane >> 4), e = F.lane & 15; float lg = 0.f;
#pragma unroll
            for (int w = 0; w < 8; ++w) lg += PLG[((par * 8 + w) * 16 + rl) * 16 + e];
            float mx = lg;
#pragma unroll
            for (int o = 1; o < 16; o <<= 1) mx = fmaxf(mx, __shfl_xor(mx, o));
            const float ex = __expf(lg - mx); float den = ex;
#pragma unroll
            for (int o = 1; o < 16; o <<= 1) den += __shfl_xor(den, o);
            AFF[(size_t)(row0 + rl) * 16 + e] = ex / den; }
      }
    }
    __syncthreads();
}

__device__ __forceinline__ int blk_sum(LAS int* buf, int wave, int lane, int v_wave_total) {
    if (lane == 0) buf[wave] = v_wave_total;
    __syncthreads();
    int t = 0;
#pragma unroll
    for (int w = 0; w < 8; ++w) t += buf[w];
    return t;
}
__device__ __forceinline__ void tk_phase(const Frame& F0, bool with_ctx) {
    PHASE_FRAME(F0);
    LAS int* cb = (LAS int*)F.lds;
    const float* AFF = (const float*)(F.ws + WS_AFF);
    unsigned* IDX = (unsigned*)(F.ws + WS_IDX); float* GATE = (float*)(F.ws + WS_GATE); unsigned short* TOKSLOT = (unsigned short*)(F.ws + WS_TOKSLOT);
    for (int p = blockIdx.x; p < 256; p += F.G) {
        const int e = p >> 4, b = p & 15, row0 = b * SEQ, crow0 = NLAT + b * CTXL;
        const bool cw = with_ctx && F.wave == 0;
        unsigned key[4], ckey[4];
#pragma unroll
        for (int k = 0; k < 4; ++k) { key[k] = __float_as_uint(AFF[(size_t)(row0 + 4 * F.tid + k) * 16 + e]); ckey[k] = cw ? __float_as_uint(AFF[(size_t)(crow0 + 4 * F.lane + k) * 16 + e]) : 0u; }
        unsigned T = 0u, Tc = 0u;
        for (int bit = 29; bit >= 1; bit -= 2) {
            const unsigned c1 = T | (2u << bit), c2 = T | (1u << bit), c3 = T | (3u << bit);
            int n1 = 0, n2 = 0, n3 = 0;
#pragma unroll
            for (int k = 0; k < 4; ++k) { n1 += __popcll(__ballot(key[k] >= c1)); n2 += __popcll(__ballot(key[k] >= c2)); n3 += __popcll(__ballot(key[k] >= c3)); }
            if (cw) { const unsigned d1 = Tc | (2u << bit), d2 = Tc | (1u << bit), d3 = Tc | (3u << bit); int m1 = 0, m2 = 0, m3 = 0;
#pragma unroll
                for (int k = 0; k < 4; ++k) { m1 += __popcll(__ballot(ckey[k] >= d1)); m2 += __popcll(__ballot(ckey[k] >= d2)); m3 += __popcll(__ballot(ckey[k] >= d3)); }
                Tc = m3 >= 32 ? d3 : m1 >= 32 ? d1 : m2 >= 32 ? d2 : Tc; }
            LAS int* buf = cb + 64 + ((bit >> 1) & 3) * 24;
            if (F.lane == 0) { buf[F.wave * 3] = n1; buf[F.wave * 3 + 1] = n2; buf[F.wave * 3 + 2] = n3; }
            __syncthreads();
            int t1 = 0, t2 = 0, t3 = 0;
#pragma unroll
            for (int w = 0; w < 8; ++w) { t1 += buf[w * 3]; t2 += buf[w * 3 + 1]; t3 += buf[w * 3 + 2]; }
            T = t3 >= 256 ? c3 : t1 >= 256 ? c1 : t2 >= 256 ? c2 : T;
        }
        { const unsigned cand = T | 1u;
            int c = 0;
#pragma unroll
            for (int k = 0; k < 4; ++k) c += __popcll(__ballot(key[k] >= cand));
            if (cw) { const unsigned cc = Tc | 1u; int n = 0;
#pragma unroll
                for (int k = 0; k < 4; ++k) n += __popcll(__ballot(ckey[k] >= cc));
                if (n >= 32) Tc = cc; }
            const int tot = blk_sum(cb, F.wave, F.lane, c);
            if (tot >= 256) T = cand;
        }
        const unsigned long long lt = (1ull << F.lane) - 1ull;
        if (cw) {
            int ngt = 0;
#pragma unroll
            for (int k = 0; k < 4; ++k) ngt += __popcll(__ballot(ckey[k] > Tc));
            const int need = 32 - ngt; int run = 0;
#pragma unroll
            for (int k = 0; k < 4; ++k) run += __popcll(__ballot(ckey[k] == Tc) & lt);
            bool sel[4];
#pragma unroll
            for (int k = 0; k < 4; ++k) { const bool iseq = ckey[k] == Tc; sel[k] = (ckey[k] > Tc) || (iseq && run < need); run += iseq ? 1 : 0; }
            int slot = 0;
#pragma unroll
            for (int k = 0; k < 4; ++k) slot += __popcll(__ballot(sel[k]) & lt);
            const int tile = 256 + e * 2 + (b >> 3), sbase = (b & 7) * 32;
#pragma unroll
            for (int k = 0; k < 4; ++k) { const int t = 4 * F.lane + k; unsigned short ts = 0xFFFFu;
                if (sel[k]) { const int s_ = sbase + slot; ts = (unsigned short)s_; const size_t S = (size_t)tile * 256 + s_;
                    IDX[S] = (unsigned)(crow0 + t) * 1024u; GATE[S] = __uint_as_float(ckey[k]); ++slot; }
                TOKSLOT[(size_t)e * NROWS + crow0 + t] = ts; }
        }
        int cgt = 0;
#pragma unroll
        for (int k = 0; k < 4; ++k) cgt += __popcll(__ballot(key[k] > T));
        const int ngt = blk_sum(cb + 32, F.wave, F.lane, cgt);
        const int need = 256 - ngt;
        unsigned long long mq[4]; int weq = 0, leq = 0;
#pragma unroll
        for (int k = 0; k < 4; ++k) { mq[k] = __ballot(key[k] == T); weq += __popcll(mq[k]); leq += __popcll(mq[k] & lt); }
        if (F.lane == 0) cb[40 + F.wave] = weq;
        __syncthreads();
        int eqbase = leq;
        for (int w = 0; w < F.wave; ++w) eqbase += cb[40 + w];
        bool sel[4]; int run = eqbase;
#pragma unroll
        for (int k = 0; k < 4; ++k) { const bool iseq = key[k] == T; sel[k] = (key[k] > T) || (iseq && run < need); run += iseq ? 1 : 0; }
        unsigned long long ms[4]; int wsel = 0, lsel = 0;
#pragma unroll
        for (int k = 0; k < 4; ++k) { ms[k] = __ballot(sel[k]); wsel += __popcll(ms[k]); lsel += __popcll(ms[k] & lt); }
        if (F.lane == 0) cb[48 + F.wave] = wsel;
        __syncthreads();
        int slot = lsel;
        for (int w = 0; w < F.wave; ++w) slot += cb[48 + w];
#pragma unroll
        for (int k = 0; k < 4; ++k) { const int t = 4 * F.tid + k; unsigned short ts = 0xFFFFu;
            if (sel[k]) { ts = (unsigned short)slot; const size_t S = (size_t)p * 256 + slot;
                IDX[S] = (unsigned)(row0 + t) * 1024u;   GATE[S] = __uint_as_float(key[k]); ++slot; }
            TOKSLOT[(size_t)e * NROWS + row0 + t] = ts; }
        __syncthreads();
    }
}

__device__ __forceinline__ void conv_phase(const Frame& F0, int jl, int nrows) {
    PHASE_FRAME(F0);
    const int gw = blockIdx.x * 8 + F.wave, NGW = F.G * 4, RPW = nrows / NGW, rbeg = (gw >> 1) * RPW, c0 = 512 * (gw & 1) + 8 * F.lane;
    const bf16_t* BG = (const bf16_t*)(F.ws + WS_BG) + c0; const bf16_t* U = (const bf16_t*)(F.ws + WS_U) + c0; bf16_t* H = (bf16_t*)(F.ws + WS_H) + c0;
    const float* ck = inp(F, I_CK) + (size_t)jl * 3 * 1024 + c0; const float* cbias = inp(F, I_CB) + (size_t)jl * 1024 + c0;
    f32x4 k0[2], k1[2], k2[2], cb[2];
#pragma unroll
    for (int q = 0; q < 2; ++q) { k0[q] = *(const f32x4*)(ck + 4 * q); k1[q] = *(const f32x4*)(ck + 1024 + 4 * q); k2[q] = *(const f32x4*)(ck + 2048 + 4 * q); cb[q] = *(const f32x4*)(cbias + 4 * q); }
    u32x4 U0, U1, U2, U3, U4, U5, B0, B1, B2, B3, B4, B5;
    const int rlast = rbeg + RPW < nrows ? rbeg + RPW : nrows - 1;
#define CV_LDU(UB, i) do { int r_ = rbeg + (i); r_ = r_ < 0 ? 0 : (r_ > rlast ? rlast : r_); UB = *(const GAS u32x4*)(U + (size_t)r_ * D); } while (0)
#define CV_LDB(BB, i) do { const int r_ = rbeg + ((i) < RPW ? (i) : RPW - 1); BB = *(const GAS u32x4*)(BG + (size_t)r_ * D); } while (0)
#define CV_STEP(i, UP, UC, UN, UI, BC, BI) do { const int i_ = (i), row = rbeg + i_; CV_LDU(UI, i_ + 4); CV_LDB(BI, i_ + 3); \
        const bool lat = row < NLAT; const int t = lat ? (row & (SEQ - 1)) : ((row - NLAT) & (CTXL - 1)), n = lat ? SEQ : CTXL; const bool hp = t > 0, hn = t < n - 1; \
        u32x4 o; \
        _Pragma("unroll") for (int q = 0; q < 4; ++q) { const int h = q >> 1, e = 2 * (q & 1); \
            const float p0 = hp ? bf_lo(UP[q]) : 0.f, p1 = hp ? bf_hi(UP[q]) : 0.f, n0 = hn ? bf_lo(UN[q]) : 0.f, n1 = hn ? bf_hi(UN[q]) : 0.f; \
            const float y0 = k0[h][e] * p0 + k1[h][e] * bf_lo(UC[q]) + k2[h][e] * n0 + cb[h][e]; \
            const float y1 = k0[h][e + 1] * p1 + k1[h][e + 1] * bf_hi(UC[q]) + k2[h][e + 1] * n1 + cb[h][e + 1]; \
            o[q] = pk2(bf_lo(BC[q]) * y0, bf_hi(BC[q]) * y1); } \
        *(GAS u32x4*)(H + (size_t)row * D) = o; } while (0)
    CV_LDU(U5, -1); CV_LDU(U0, 0); CV_LDU(U1, 1); CV_LDB(B0, 0); CV_LDU(U2, 2); CV_LDB(B1, 1); CV_LDU(U3, 3); CV_LDB(B2, 2);
    int i = 0;
    for (; i + 5 < RPW; i += 6) {
        CV_STEP(i,     U5, U0, U1, U4, B0, B3); CV_STEP(i + 1, U0, U1, U2, U5, B1, B4); CV_STEP(i + 2, U1, U2, U3, U0, B2, B5);
        CV_STEP(i + 3, U2, U3, U4, U1, B3, B0); CV_STEP(i + 4, U3, U4, U5, U2, B4, B1); CV_STEP(i + 5, U4, U5, U0, U3, B5, B2);
    }
    if (i < RPW) { CV_STEP(i, U5, U0, U1, U4, B0, B3);
        if (i + 1 < RPW) { CV_STEP(i + 1, U0, U1, U2, U5, B1, B4);
            if (i + 2 < RPW) { CV_STEP(i + 2, U1, U2, U3, U0, B2, B5);
                if (i + 3 < RPW) { CV_STEP(i + 3, U2, U3, U4, U1, B3, B0);
                    if (i + 4 < RPW) { CV_STEP(i + 4, U3, U4, U5, U2, B4, B1); } } } } }
#undef CV_STEP
#undef CV_LDB
#undef CV_LDU
}

__device__ __forceinline__ void att_naive_phase(const Frame& F0, int jl) {
    PHASE_FRAME(F0);
    bf16_t* Q = (bf16_t*)(F.ws + WS_Q); const bf16_t* K = (const bf16_t*)(F.ws + WS_K); const bf16_t* V = (const bf16_t*)(F.ws + WS_V);
    LAS unsigned* Kt = (LAS unsigned*)F.lds; LAS unsigned* Vt = Kt + 2048;
    const int qi = F.tid & 255, half = F.wave >> 2;
    for (int u = blockIdx.x; u < 2304; u += F.G) {
        int type, b, h, qrow, qcol, kvcol, qpos, ts = 0, NT; float sink2 = -INFINITY;
        if (u < 2048) { type = u >> 10; const int w = u & 1023; b = w >> 6; h = (w >> 3) & 7; const int qc = w & 7; qpos = qc * 256 + qi; qrow = b * SEQ + qpos;
            qcol = (type * 8 + h) * HD; kvcol = (type * 2 + (h >> 2)) * HD;
            if (type == 0) NT = 36; else { const int t0 = qc * 4; ts = t0 - 2 < 0 ? 0 : t0 - 2; const int te = t0 + 6 > 32 ? 32 : t0 + 6; NT = 4 + (te - ts); sink2 = inp(F, I_SINK)[jl * 8 + h] * LOG2E; } }
        else { type = 2; const int w = u - 2048; b = w >> 4; const int g = (w >> 3) & 1; h = w & 7; qpos = qi; qrow = NLAT + b * CTXL + qpos;
            qcol = (g * 8 + h) * HD; kvcol = (g * 2 + (h >> 2)) * HD; NT = 4; if (g) sink2 = inp(F, I_SINK)[jl * 8 + h] * LOG2E; }
        const int kvrow0 = b * KVLEN;
        float o[32]; u32x4 qk[8];
        { const u32x4* qp = (const u32x4*)(Q + (size_t)qrow * D + qcol);
#pragma unroll
          for (int i = 0; i < 8; ++i) qk[i] = qp[i]; }
#pragma unroll
        for (int d = 0; d < 32; ++d) o[d] = 0.f;
        float m = -1e30f, l = 0.f;
        for (int ti = 0; ti < NT; ++ti) {
            int tile; bool band = false;
            if (type == 0) tile = ti; else if (ti < 4) tile = 32 + ti; else { tile = ts + (ti - 4); band = true; }
            __syncthreads();
            { const int r = F.tid >> 3, c = F.tid & 7; const size_t off = (size_t)(kvrow0 + tile * 64 + r) * KVP + kvcol + c * 8;
              *(LAS u32x4*)(Kt + r * 32 + c * 4) = *(const u32x4*)(K + off); *(LAS u32x4*)(Vt + r * 32 + c * 4) = *(const u32x4*)(V + off); }
            __syncthreads();
#pragma unroll 1
            for (int kq = 0; kq < 16; ++kq) {
                float s[4];
#pragma unroll
                for (int i = 0; i < 8; ++i) asm volatile("" : "+v"(qk[i]));
#pragma unroll
                for (int kk = 0; kk < 4; ++kk) { const LAS u32x4* kp = (const LAS u32x4*)(Kt + (kq * 4 + kk) * 32); float a = 0.f;
#pragma unroll
                    for (int i = 0; i < 8; ++i) { const u32x4 w = kp[i];
#pragma unroll
                        for (int c = 0; c < 4; ++c) { a += bf_lo(qk[i][c]) * bf_lo(w[c]); a += bf_hi(qk[i][c]) * bf_hi(w[c]); } }
                    if (band) { const int kpos = tile * 64 + kq * 4 + kk, dd = kpos - qpos; if (dd > 128 || dd < -128) a = -1e30f; }
                    s[kk] = a; }
                const float cm = fmaxf(fmaxf(s[0], s[1]), fmaxf(s[2], s[3]));
                const float mn = fmaxf(m, cm), sc = __builtin_amdgcn_exp2f(m - mn);
                l *= sc;
#pragma unroll
                for (int d = 0; d < 32; ++d) o[d] *= sc;
#pragma unroll
                for (int kk = 0; kk < 4; ++kk) { const float p = __builtin_amdgcn_exp2f(s[kk] - mn); l += p; const LAS u32x4* vp = (const LAS u32x4*)(Vt + (kq * 4 + kk) * 32 + half * 16);
#pragma unroll
                    for (int i = 0; i < 4; ++i) { const u32x4 w = vp[i];
#pragma unroll
                        for (int c = 0; c < 4; ++c) { o[8 * i + 2 * c] += p * bf_lo(w[c]); o[8 * i + 2 * c + 1] += p * bf_hi(w[c]); } } }
                m = mn;
                asm volatile("" ::: "memory");
            }
        }
        l += __builtin_amdgcn_exp2f(sink2 - m);
        const float rl = 1.0f / l;
        __syncthreads();
        { u32x4* op = (u32x4*)((bf16_t*)(F.ws + WS_H) + (size_t)qrow * D + qcol + half * 32);
#pragma unroll
            for (int i = 0; i < 4; ++i) { u32x4 w;
#pragma unroll
                for (int c = 0; c < 4; ++c) w[c] = pk2(o[8 * i + 2 * c] * rl, o[8 * i + 2 * c + 1] * rl);
                op[i] = w; } }
    }
    __syncthreads();
}

namespace attn_body {
using bf16=__hip_bfloat16;
using bf16x8=__attribute__((ext_vector_type(8)))short;
using s16x4=__attribute__((ext_vector_type(4)))short;
using f32x16=__attribute__((ext_vector_type(16)))float;
using u32x4=__attribute__((ext_vector_type(4)))unsigned;
constexpr int D=64,DM=1024,KVPT=256;
constexpr int NW=8,QBLK=32,QB=QBLK*NW,KVBLK=64;
__device__ __forceinline__ int crow(int r,int hi){return (r&3)+8*(r>>2)+4*hi;}
#define SBAR() __builtin_amdgcn_sched_barrier(0)
__device__ __forceinline__ void wmask(f32x16&p0,f32x16&p1,int krel,int qrel,int hi,int wid){
  const int dlo=krel-(32*wid+31), dhi=krel+63-32*wid;
  if(dlo>=-128&&dhi<=128)return;
  float xf=(float)(krel+4*hi-qrel); asm volatile("":"+v"(xf));
  #pragma unroll
  for(int r=0;r<16;++r){const float c=(float)((r&3)+8*(r>>2));
    p0[r]=__builtin_fmaf(__builtin_fminf(128.f-__builtin_fabsf(xf+c),0.f),1e30f,p0[r]);
    p1[r]=__builtin_fmaf(__builtin_fminf(128.f-__builtin_fabsf(xf+(c+32.f)),0.f),1e30f,p1[r]);}
}
struct AttU { int qrow0,qcol,kvrow0,kvcol,NT,tA,nA,tB,nband,krel0,wqm,whs,hs; float skv; };

constexpr int NSLOT=3, SLOTB=8192;
constexpr int LDS_K=0, LDS_V=NSLOT*SLOTB, LDS_WS=2*NSLOT*SLOTB, LDS_OST=LDS_WS+NW*64*4, LDS_BYTES=LDS_OST+NW*4096;
__device__ __forceinline__ void glds16(const void*gsrc,unsigned lds_dst){unsigned keep;
  asm volatile("s_mov_b32 %0, m0\n\ts_mov_b32 m0, %2\n\ts_nop 0\n\tglobal_load_lds_dwordx4 %1, off\n\ts_mov_b32 m0, %0":"=&s"(keep):"v"(gsrc),"s"(lds_dst):"memory");}
__device__ __forceinline__ float max3f(float a,float b,float c){float r;asm("v_max3_f32 %0, %1, %2, %3":"=v"(r):"v"(a),"v"(b),"v"(c));return r;}
__device__ __forceinline__ float max2f(float a,float b){float r;asm("v_max_f32_e32 %0, %1, %2":"=v"(r):"v"(a),"v"(b));return r;}
__device__ __forceinline__ float fadd_s(float a,float b){float r;asm("v_add_f32_e32 %0, %1, %2":"=v"(r):"v"(a),"v"(b));return r;}
__device__ __forceinline__ float fsub_s(float a,float b){float r;asm("v_sub_f32_e32 %0, %1, %2":"=v"(r):"v"(a),"v"(b));return r;}
typedef float f32x2_t __attribute__((ext_vector_type(2))); typedef __bf16 bf16x2_t __attribute__((ext_vector_type(2)));
__device__ __forceinline__ unsigned cvtpk_s(float lo,float hi){f32x2_t v={lo,hi};bf16x2_t b=__builtin_convertvector(v,bf16x2_t);return __builtin_bit_cast(unsigned,b);}
#define WAIT_BAR(N) asm volatile("s_waitcnt vmcnt(" #N ") lgkmcnt(0)\n\ts_barrier":::"memory")

__device__ __forceinline__ void qkt(f32x16&p0,f32x16&p1,const char*Kslot,const bf16x8*qr,const f32x16&negm,int r32,int hi){
  const char*kb=Kslot+hi*1024+r32*16;
  #pragma unroll
  for(int d0=0;d0<4;++d0){
    const bf16x8 b0=*reinterpret_cast<const bf16x8*>(kb+d0*2048);
    const bf16x8 b1=*reinterpret_cast<const bf16x8*>(kb+d0*2048+512);
    if(d0==0){p0=__builtin_amdgcn_mfma_f32_32x32x16_bf16(b0,qr[0],negm,0,0,0);p1=__builtin_amdgcn_mfma_f32_32x32x16_bf16(b1,qr[0],negm,0,0,0);}
    else{p0=__builtin_amdgcn_mfma_f32_32x32x16_bf16(b0,qr[d0],p0,0,0,0);p1=__builtin_amdgcn_mfma_f32_32x32x16_bf16(b1,qr[d0],p1,0,0,0);}}
}
typedef __attribute__((address_space(3))) const char* lds_cptr;
typedef short v4i16_t __attribute__((ext_vector_type(4)));
__device__ __forceinline__ void kload8(bf16x8*kf,lds_cptr kp){
  kf[0]=*(const __attribute__((address_space(3))) bf16x8*)(kp);      kf[1]=*(const __attribute__((address_space(3))) bf16x8*)(kp+512);
  kf[2]=*(const __attribute__((address_space(3))) bf16x8*)(kp+2048); kf[3]=*(const __attribute__((address_space(3))) bf16x8*)(kp+2560);
  kf[4]=*(const __attribute__((address_space(3))) bf16x8*)(kp+4096); kf[5]=*(const __attribute__((address_space(3))) bf16x8*)(kp+4608);
  kf[6]=*(const __attribute__((address_space(3))) bf16x8*)(kp+6144); kf[7]=*(const __attribute__((address_space(3))) bf16x8*)(kp+6656);
}
__device__ __forceinline__ void kload2(bf16x8*kf,lds_cptr kp,int j){ kf[2*j]=*(const __attribute__((address_space(3))) bf16x8*)(kp+j*2048); kf[2*j+1]=*(const __attribute__((address_space(3))) bf16x8*)(kp+j*2048+512); }
__device__ __forceinline__ s16x4 vtr(lds_cptr p){ return __builtin_bit_cast(s16x4,__builtin_amdgcn_ds_read_tr16_b64_v4i16((__attribute__((address_space(3))) v4i16_t*)p)); }
__device__ __forceinline__ float rowmax(const f32x16&p0,const f32x16&p1){
  float a=max3f(p0[0],p0[1],p1[0]),b=max3f(p0[2],p0[3],p1[1]);a=max3f(a,p1[2],p1[3]);
  #pragma unroll
  for(int r=4;r<16;r+=4){a=max3f(a,p0[r],p0[r+1]);b=max3f(b,p0[r+2],p0[r+3]);a=max3f(a,p1[r],p1[r+1]);b=max3f(b,p1[r+2],p1[r+3]);}
  const float m=max2f(a,b);
  auto rr=__builtin_amdgcn_permlane32_swap(__float_as_uint(m),__float_as_uint(m),false,false);
  return max2f(__uint_as_float(rr[0]),__uint_as_float(rr[1]));
}
__device__ __forceinline__ void pv(f32x16*o,int vb,bf16x8 pa0,bf16x8 pa1,bf16x8 pa2,bf16x8 pa3){
  #pragma unroll
  for(int d0=0;d0<2;++d0){s16x4 lo[4],hi[4];
    #pragma unroll
    for(int ks=0;ks<4;++ks){
      asm volatile("ds_read_b64_tr_b16 %0,%1 offset:%c2":"=&v"(lo[ks]):"v"(vb),"i"(d0*4096+ks*1024):"memory");
      asm volatile("ds_read_b64_tr_b16 %0,%1 offset:%c2":"=&v"(hi[ks]):"v"(vb),"i"(d0*4096+ks*1024+512):"memory");}
    asm volatile("s_waitcnt lgkmcnt(0)":::"memory");SBAR();
    #define PK(k) (bf16x8){lo[k][0],lo[k][1],lo[k][2],lo[k][3],hi[k][0],hi[k][1],hi[k][2],hi[k][3]}
    o[d0]=__builtin_amdgcn_mfma_f32_32x32x16_bf16(pa0,PK(0),o[d0],0,0,0);
    o[d0]=__builtin_amdgcn_mfma_f32_32x32x16_bf16(pa1,PK(1),o[d0],0,0,0);
    o[d0]=__builtin_amdgcn_mfma_f32_32x32x16_bf16(pa2,PK(2),o[d0],0,0,0);
    o[d0]=__builtin_amdgcn_mfma_f32_32x32x16_bf16(pa3,PK(3),o[d0],0,0,0);
    #undef PK
  }
}

#ifndef ATTN_STORE16
#define ATTN_STORE16(p,v) (*(u32x4*)(p)=(v))
#endif
template<int THRL> __device__ __forceinline__ void attn_unit(const AttU&U,const bf16*Q,const bf16*__restrict__ K,const bf16*__restrict__ V,bf16*O,char*shm){
  int tid_=threadIdx.x; asm volatile("":"+v"(tid_)); const int tid=tid_,lane=tid&63,r32=lane&31,hi=lane>>5; const int wid=__builtin_amdgcn_readfirstlane(tid>>6);
  const int NT=U.NT,nA=U.nA,tA=U.tA,tB=U.tB,nband=U.nband,krel0=U.krel0;
  const int wq=wid&U.wqm, wh=wid>>U.whs;
  const bf16*Qw=Q+((long)U.qrow0+wq*QBLK)*DM+U.qcol+wh*D;
  const bf16*Kh=K+(long)U.kvrow0*KVPT+U.kvcol,*Vh=V+(long)U.kvrow0*KVPT+U.kvcol;
  const unsigned lds0=(unsigned)(uintptr_t)shm;
  float*wsf=(float*)(shm+LDS_WS)+wid*64;
  const bf16*ksrc=Kh+(long)lane*KVPT+wid*8;
  const bf16*vsrc=Vh+(long)(16*(wid&3)+(lane>>2))*KVPT+(wid>>2)*32+(lane&3)*8;
  const unsigned kdst=lds0+LDS_K+wid*1024, vdst=lds0+LDS_V+wid*1024;
  #define TILE(t) ((t)<nA?tA+(t):tB+((t)-nA))
  #define DMA_K(t,slot) glds16(ksrc+(long)TILE(t)*(KVBLK*KVPT),(unsigned)__builtin_amdgcn_readfirstlane(kdst+(slot)))
  #define DMA_V(t,slot) glds16(vsrc+(long)TILE(t)*(KVBLK*KVPT),(unsigned)__builtin_amdgcn_readfirstlane(vdst+(slot)))
  const int vb0=(int)(lds0+LDS_V)+((lane>>4)&1)*32+(lane&3)*8+(4*hi+((lane&15)>>2))*64;
  const char*Kbase=shm+LDS_K; bf16x8 kf[8];
  const lds_cptr shm3=(lds_cptr)shm; const lds_cptr kp0=shm3+LDS_K+hi*1024+r32*16; const lds_cptr vp0=shm3+LDS_V+((lane>>4)&1)*32+(lane&3)*8+(4*hi+((lane&15)>>2))*64;
  DMA_K(0,0);DMA_V(0,0);DMA_K(1,SLOTB);
  bf16x8 qr[4];
  #pragma unroll
  for(int d0=0;d0<4;++d0)qr[d0]=*reinterpret_cast<const bf16x8*>(&Qw[(long)r32*DM+d0*16+hi*8]);
  float mhat=0.f,l_reg=0.f;f32x16 o[2];o[0]=f32x16{};o[1]=f32x16{};f32x16 negm=f32x16{};asm volatile("":"+v"(negm));
  const int qrel=wq*QBLK+r32;
  #define CMASK(P0,P1,t) do{int jb_=(t)-(NT-nband); if(jb_>=0)wmask(P0,P1,krel0+64*jb_,qrel,hi,wq);}while(0)
  bool resc=false;
  #define START(P0,P1) do{ const float rm=rowmax(P0,P1); resc=false; \
    { const float dl=rm; mhat=fadd_s(mhat,dl); \
      _Pragma("unroll") for(int r=0;r<16;++r){P0[r]=fsub_s(P0[r],dl);P1[r]=fsub_s(P1[r],dl);} \
      _Pragma("unroll") for(int r=0;r<16;++r)negm[r]=-mhat; asm volatile("":"+v"(negm)); } \
    _Pragma("unroll") for(int r=0;r<16;++r)P0[r]=__builtin_amdgcn_exp2f(P0[r]); }while(0)
  #define RESC() do{ if(resc){ asm volatile("s_waitcnt lgkmcnt(0)":::"memory"); \
      _Pragma("unroll") for(int d_=0;d_<2;++d_) _Pragma("unroll") for(int r=0;r<16;++r)o[d_][r]*=wsf[crow(r,hi)]; } }while(0)
  f32x16 pA0,pA1,pB0,pB1;
  int sl_prev=0,sl_cur=0,sl_next=SLOTB;
  #define ROT() do{sl_prev=sl_cur;sl_cur=sl_next;sl_next=(sl_next==(NSLOT-1)*SLOTB)?0:sl_next+SLOTB;}while(0)
  DMA_K(2,2*SLOTB);
  WAIT_BAR(3);
  qkt(pA0,pA1,Kbase,qr,negm,r32,hi);asm volatile("s_nop 15\n\ts_nop 7":"+v"(pA0),"+v"(pA1));CMASK(pA0,pA1,0);
  START(pA0,pA1);
  _Pragma("unroll") for(int r=0;r<16;++r)pA1[r]=__builtin_amdgcn_exp2f(pA1[r]);
  WAIT_BAR(0);
  DMA_K(3,0);DMA_V(1,SLOTB);
  ROT();
  kload8(kf,kp0+sl_cur);
  WAIT_BAR(2);
  s16x4 vlo[8],vhi[8]; u32x4 pw0,pw1,pw2,pw3;
  #define PKW(P,B) cvtpk_s(P[B],P[B+1])
  #define PAF(k) __builtin_bit_cast(bf16x8,pw##k)
  #define VFR(i) (bf16x8){vlo[i][0],vlo[i][1],vlo[i][2],vlo[i][3],vhi[i][0],vhi[i][1],vhi[i][2],vhi[i][3]}
  #define PIN(x) asm volatile("":"+v"(x))
  #define MX3(a,b,c) __builtin_fmaxf(__builtin_fmaxf((a),(b)),(c))
  #define GAPA(MF,A0,A1,A2,A3,W0,W1,PW) do{ MF; sacc+=A0; sacc+=A1; sacc+=A2; sacc+=A3; PIN(sacc); W0; W1; PIN(PW); SBAR(); }while(0)
  #define EX(v) __builtin_amdgcn_exp2f(v)
  #define GAPB(MF,X,B) do{ MF; X[B]=EX(X[B]); X[B+1]=EX(X[B+1]); X[B+2]=EX(X[B+2]); X[B+3]=EX(X[B+3]); PIN(X); SBAR(); }while(0)
  #define VRD(i) do{ vlo[i]=vtr(vp_+(((i)>>2)*4096+((i)&3)*1024)); vhi[i]=vtr(vp_+(((i)>>2)*4096+((i)&3)*1024+512)); }while(0)
  #define KRD(G,j) do{ if(G){ kload2(kf,kp0+sl_next,j); SBAR(); } }while(0)
  #define STEP(C0,C1,P0,P1,t,GK,GV,GL) do{ SBAR(); \
    const lds_cptr vp_=vp0+sl_prev; \
    VRD(0); SBAR(); float sacc=(P0[0]+P0[1]); \
    GAPA(C0=__builtin_amdgcn_mfma_f32_32x32x16_bf16(kf[0],qr[0],negm,0,0,0), P0[2],P0[3],P0[4],P0[5],     pw0[0]=PKW(P0,0), pw0[1]=PKW(P0,2), pw0); \
    VRD(4); SBAR(); GAPA(C1=__builtin_amdgcn_mfma_f32_32x32x16_bf16(kf[1],qr[0],negm,0,0,0), P0[6],P0[7],P0[8],P0[9],     pw0[2]=PKW(P0,4), pw0[3]=PKW(P0,6), pw0); \
    VRD(1); SBAR(); GAPA(C0=__builtin_amdgcn_mfma_f32_32x32x16_bf16(kf[2],qr[1],C0,0,0,0),   P0[10],P0[11],P0[12],P0[13], pw1[0]=PKW(P0,8), pw1[1]=PKW(P0,10), pw1); \
    VRD(5); SBAR(); GAPA(C1=__builtin_amdgcn_mfma_f32_32x32x16_bf16(kf[3],qr[1],C1,0,0,0),   P0[14],P0[15],P1[0],P1[1],   pw1[2]=PKW(P0,12),pw1[3]=PKW(P0,14), pw1); \
    VRD(2); SBAR(); GAPA(C0=__builtin_amdgcn_mfma_f32_32x32x16_bf16(kf[4],qr[2],C0,0,0,0),   P1[2],P1[3],P1[4],P1[5],     pw2[0]=PKW(P1,0), pw2[1]=PKW(P1,2), pw2); \
    VRD(6); SBAR(); GAPA(C1=__builtin_amdgcn_mfma_f32_32x32x16_bf16(kf[5],qr[2],C1,0,0,0),   P1[6],P1[7],P1[8],P1[9],     pw2[2]=PKW(P1,4), pw2[3]=PKW(P1,6), pw2); \
    VRD(3); SBAR(); GAPA(C0=__builtin_amdgcn_mfma_f32_32x32x16_bf16(kf[6],qr[3],C0,0,0,0),   P1[10],P1[11],P1[12],P1[13], pw3[0]=PKW(P1,8), pw3[1]=PKW(P1,10), pw3); \
    VRD(7); SBAR(); GAPA(C1=__builtin_amdgcn_mfma_f32_32x32x16_bf16(kf[7],qr[3],C1,0,0,0),   P1[14],P1[15],0.f,0.f,       pw3[2]=PKW(P1,12),pw3[3]=PKW(P1,14), pw3); \
    l_reg+=sacc; \
    if(GK){DMA_K((t)+3,sl_cur);} if(GV){DMA_V((t)+1,sl_next);} \
    CMASK(C0,C1,t); \
    { float a=MX3(C0[0],C0[1],C1[0]),b=MX3(C0[2],C0[3],C1[1]); a=MX3(a,C1[2],C1[3]); \
      _Pragma("unroll") for(int r=4;r<16;r+=4){a=MX3(a,C0[r],C0[r+1]);b=MX3(b,C0[r+2],C0[r+3]);a=MX3(a,C1[r],C1[r+1]);b=MX3(b,C1[r+2],C1[r+3]);} \
      float rm=__builtin_fmaxf(a,b); { auto rr=__builtin_amdgcn_permlane32_swap(__float_as_uint(rm),__float_as_uint(rm),false,false); rm=__builtin_fmaxf(__uint_as_float(rr[0]),__uint_as_float(rr[1])); } \
      resc=false; \
      if(__builtin_expect(__any(rm>(float)THRL),0)){ const float dl=__builtin_fmaxf(rm,0.f); mhat+=dl; \
        _Pragma("unroll") for(int r=0;r<16;++r){C0[r]-=dl;C1[r]-=dl;} \
        _Pragma("unroll") for(int r=0;r<16;++r)negm[r]=-mhat; asm volatile("":"+v"(negm)); \
        const float f=__builtin_amdgcn_exp2f(-dl); l_reg*=f; if(hi==0)wsf[r32]=f; resc=true; } } \
    SBAR(); \
    GAPB(o[0]=__builtin_amdgcn_mfma_f32_32x32x16_bf16(PAF(0),VFR(0),o[0],0,0,0), C0,0); \
    GAPB(o[1]=__builtin_amdgcn_mfma_f32_32x32x16_bf16(PAF(0),VFR(4),o[1],0,0,0), C0,4); \
    KRD(GL,0); GAPB(o[0]=__builtin_amdgcn_mfma_f32_32x32x16_bf16(PAF(1),VFR(1),o[0],0,0,0), C0,8); \
    KRD(GL,1); GAPB(o[1]=__builtin_amdgcn_mfma_f32_32x32x16_bf16(PAF(1),VFR(5),o[1],0,0,0), C0,12); \
    KRD(GL,2); GAPB(o[0]=__builtin_amdgcn_mfma_f32_32x32x16_bf16(PAF(2),VFR(2),o[0],0,0,0), C1,0); \
    KRD(GL,3); GAPB(o[1]=__builtin_amdgcn_mfma_f32_32x32x16_bf16(PAF(2),VFR(6),o[1],0,0,0), C1,4); \
    GAPB(o[0]=__builtin_amdgcn_mfma_f32_32x32x16_bf16(PAF(3),VFR(3),o[0],0,0,0), C1,8); \
    GAPB(o[1]=__builtin_amdgcn_mfma_f32_32x32x16_bf16(PAF(3),VFR(7),o[1],0,0,0), C1,12); \
    }while(0)
  int t=1;
  #undef CMASK
  #define CMASK(P0,P1,t) do{}while(0)
  const int tend=__builtin_amdgcn_readfirstlane((NT-5)<(NT-nband-1)?(NT-5):(NT-nband-1));
  for(;t<tend;t+=2){
    STEP(pB0,pB1,pA0,pA1,t,true,true,true);     WAIT_BAR(2); RESC(); ROT();
    STEP(pA0,pA1,pB0,pB1,t+1,true,true,true);   WAIT_BAR(2); RESC(); ROT();
  }
  #undef CMASK
  #define CMASK(P0,P1,t) do{int jb_=(t)-(NT-nband); if(jb_>=0)wmask(P0,P1,krel0+64*jb_,qrel,hi,wq);}while(0)
  #define ENDW(tt) do{ if((tt)+3<NT){WAIT_BAR(2);} else if((tt)+2<NT){WAIT_BAR(1);} else {WAIT_BAR(0);} }while(0)
  for(;t+1<NT;t+=2){
    STEP(pB0,pB1,pA0,pA1,t,(t+3<NT),(t+1<NT),(t+1<NT));       ENDW(t);   RESC(); ROT();
    STEP(pA0,pA1,pB0,pB1,t+1,(t+4<NT),(t+2<NT),(t+2<NT));     ENDW(t+1); RESC(); ROT();
  }
  STEP(pB0,pB1,pA0,pA1,NT-1,false,false,false); RESC();
  { float sacc=pB0[0]+pB0[1]; _Pragma("unroll") for(int r=2;r<16;++r)sacc+=pB0[r]; _Pragma("unroll") for(int r=0;r<16;++r)sacc+=pB1[r]; l_reg+=sacc;
    pw0=(u32x4){PKW(pB0,0),PKW(pB0,2),PKW(pB0,4),PKW(pB0,6)};pw1=(u32x4){PKW(pB0,8),PKW(pB0,10),PKW(pB0,12),PKW(pB0,14)};pw2=(u32x4){PKW(pB1,0),PKW(pB1,2),PKW(pB1,4),PKW(pB1,6)};pw3=(u32x4){PKW(pB1,8),PKW(pB1,10),PKW(pB1,12),PKW(pB1,14)};
    SBAR(); pv(o,vb0+sl_cur,PAF(0),PAF(1),PAF(2),PAF(3)); }
  #undef PKW
  #undef PAF
  #undef VFR
  #undef PIN
  #undef MX3
  #undef GAPA
  #undef GAPB
  #undef EX
  #undef VRD
  #undef KRD
  #undef STEP
  #undef ENDW
  {auto rr=__builtin_amdgcn_permlane32_swap(__float_as_uint(l_reg),__float_as_uint(l_reg),false,false);l_reg=__uint_as_float(rr[0])+__uint_as_float(rr[1]);}
  { const float sink2=__int_as_float(__builtin_amdgcn_readlane(__float_as_int(U.skv),U.hs+wh)); l_reg+=__builtin_amdgcn_exp2f(sink2-mhat); }
  if(hi==0)wsf[32+r32]=l_reg;asm volatile("s_waitcnt lgkmcnt(0)":::"memory");
  float rli[16];
  #pragma unroll
  for(int r=0;r<16;++r)rli[r]=__builtin_amdgcn_rcpf(wsf[32+crow(r,hi)]);
  unsigned char*Ow=(unsigned char*)O+((long)U.qrow0+wq*QBLK)*DM+U.qcol+wh*D;
  { unsigned char*stg=(unsigned char*)(shm+LDS_OST)+wid*4096;
    #pragma unroll
    for(int r=0;r<16;++r){const int orow=crow(r,hi);
      #pragma unroll
      for(int d0=0;d0<2;++d0){const float ov=__builtin_fminf(__builtin_fmaxf(o[d0][r]*rli[r]*64.f,-448.f),448.f); stg[orow*64+d0*32+r32]=(unsigned char)(__builtin_amdgcn_cvt_pk_fp8_f32(ov,ov,0,false)&0xff);}}
    asm volatile("s_waitcnt lgkmcnt(0)":::"memory");
    #pragma unroll
    for(int i=0;i<2;++i){const int row=i*16+(lane>>2),ch=lane&3; const u32x4 v=*(const u32x4*)(stg+row*64+ch*16); ATTN_STORE16(Ow+(long)row*DM+ch*16,v);} }
  asm volatile("s_waitcnt lgkmcnt(0)\n\ts_barrier":::"memory");
  #undef DMA_K
  #undef TILE
  #undef DMA_V
  #undef CMASK
  #undef START
  #undef RESC
  #undef ROT
}
constexpr int ATTN_LDS_BYTES=LDS_BYTES;
#undef SBAR
#undef WAIT_BAR
}
static_assert(attn_body::ATTN_LDS_BYTES <= RING_BYTES, "attention LDS");
__device__ __forceinline__ void att_fast_phase(const Frame& F0, int jl) {
    PHASE_FRAME(F0);
    const attn_body::bf16* Q = (const attn_body::bf16*)(F.ws + WS_Q); const attn_body::bf16* K = (const attn_body::bf16*)(F.ws + WS_K); const attn_body::bf16* V = (const attn_body::bf16*)(F.ws + WS_V);
    const float skv = F.lane < 8 ? ((const GAS float*)(inp(F, I_SINK) + jl * 8))[F.lane] * LOG2E : -INFINITY;
    for (int i = 0;; ++i) {
        const int lin = i * F.G + (int)blockIdx.x; if (lin >= 2304) break;
        const int slot = lin >> 8; int v = lin & 255; if (F.G == 256) v = (v & 7) * 32 + (v >> 3);
        attn_body::AttU U;
        U.wqm = 7; U.whs = 3; U.hs = 8; U.skv = skv;
        if (slot < 4) { const int bh = v >> 1, b = bh >> 3, h = bh & 7, qb = (v & 1) * 4 + slot;
            U.qrow0 = b * SEQ + qb * 256; U.qcol = h * HD; U.kvrow0 = b * KVLEN; U.kvcol = (h >> 2) * HD;
            U.NT = 36; U.tA = 0; U.nA = 36; U.tB = 0; U.nband = 0; U.krel0 = 0; }
        else if (slot < 8) { const int b = v >> 4, kvh = (v >> 3) & 1, q64 = (v & 7) * 4 + (slot & 3);
            int ts = q64 - 2 < 0 ? 0 : q64 - 2, te = q64 + 3 > 32 ? 32 : q64 + 3;
            if ((te - ts) & 1) { if (te < 32) ++te; else --ts; }
            const int nb = te - ts;
            U.qrow0 = b * SEQ + q64 * 64; U.qcol = (8 + 4 * kvh) * HD; U.kvrow0 = b * KVLEN; U.kvcol = (2 + kvh) * HD; U.wqm = 1; U.whs = 1;
            U.NT = 4 + nb; U.tA = 32; U.nA = 4; U.tB = ts; U.nband = nb; U.krel0 = ts * 64 - q64 * 64;
            U.hs = 4 * kvh; }
        else { const int b = v >> 4, g = (v >> 3) & 1, h = v & 7;
            U.qrow0 = NLAT + b * CTXL; U.qcol = (g * 8 + h) * HD; U.kvrow0 = b * KVLEN; U.kvcol = (g * 2 + (h >> 2)) * HD;
            U.NT = 4; U.tA = 32; U.nA = 4; U.tB = 0; U.nband = 0; U.krel0 = 0; if (g) U.hs = h; }
        attn_body::attn_unit<8>(U, Q, K, V, (attn_body::bf16*)(F.ws + WS_H), (char*)(unsigned char*)F.lds);
    }
}

constexpr int N_PHASES = 34;
struct Args { const float* in[23]; float* out; unsigned char* ws; int ph_lo, ph_hi; };
static_assert(sizeof(Args) == 23 * 8 + 8 + 8 + 8, "Args has no padding");

__global__ void __launch_bounds__(512, 2) mk_fwd(Args args) {
    extern __shared__ __attribute__((aligned(16))) unsigned char lds[];
    Frame F;
    F.lds = (LAS unsigned char*)lds;
    F.tid = threadIdx.x; F.lane = F.tid & 63; F.wave = __builtin_amdgcn_readfirstlane(F.tid >> 6); F.G = gridDim.x;
    F.out = args.out; F.ws = args.ws;
    unsigned char* ws = args.ws;
    volatile LAS unsigned* MISC = (volatile LAS unsigned*)(F.lds + MISC_OFF);
    for (int u = F.tid; u < (GTAB_OFF - LDSCTL_OFF) / 4; u += 512) ((LAS unsigned*)(F.lds + LDSCTL_OFF))[u] = 0u;
    __syncthreads();
    if (F.tid == 0) {
#pragma unroll
        for (int i = 0; i < 23; ++i) ((LAS unsigned long long*)(F.lds + PT_OFF))[i] = (unsigned long long)args.in[i];
    }
    __syncthreads();
    XcdBarrier bar; bar.bar = (unsigned*)(ws + WS_CTL) + CW_BAR; bar.x = 0; bar.st = nullptr;
#if !MK_PER_PHASE
    bar = xcd_barrier_post((unsigned*)(ws + WS_CTL) + CW_BAR, MISC + 8);
#endif
    const int lo = args.ph_lo, hi = args.ph_hi;
#define IN(k) (lo <= (k) && (k) < hi)
#if MK_PER_PHASE
#define SEAM(k) do { } while (0)
#else
#define SEAM(k) do { if (IN(k) && IN((k) + 1)) xcd_barrier(bar); } while (0)
#endif
    constexpr int krot = 0;
#define CV_C1(Lw) ((Lw) == 1 ? 13824 : (Lw) == 2 ? 12288 : 15360)
#define CV_C2(Lw) ((Lw) == 1 ? 20992 : (Lw) == 2 ? 18432 : 24576)
    const float* modAll = (const float*)(ws + WS_MOD);
    bf16_t* H = (bf16_t*)(ws + WS_H);

    if (IN(0)) { { p0_prologue(F); __syncthreads(); } } SEAM(0);

    for (int L = 0; L < DEPTH; ++L) {
        const int pb = 1 + 8 * L, jl = L >> 1;
        const bool with_ctx = L < DEPTH - 1;
        const int nrows = with_ctx ? NROWS : NLAT, nMt = nrows / 256;
        const float* modL = modAll + (size_t)L * 17 * 6144;


        if (IN(pb + 0)) {
            n1_phase(F, L, nrows); } SEAM(pb + 0);

        if ((L & 1) == 0) {
            if (IN(pb + 1)) {
                pg8::StaticOrder S; S.init(nMt, 6, F.G, (int)blockIdx.x);
                LAS float* ropeL = (LAS float*)(F.lds + GTAB_OFF);
                { int t_ = threadIdx.x; asm volatile("" : "+v"(t_)); *(LAS f32x4*)(ropeL + 4 * t_) = *(const GAS f32x4*)((const float*)(ws + WS_ROPE) + 4 * t_); }
                __syncthreads();
                pg8::EpiAttnIn E{(bf16_t*)(ws + WS_Q), (bf16_t*)(ws + WS_K), (bf16_t*)(ws + WS_V), (const float*)(ws + WS_GAM) + jl * 256, ropeL};
                pg8::gemm_phase<pg8::EpiAttnIn, pg8::StaticOrder, false, true, PG8_SP2, true>(F.lds, H, (const bf16_t*)(ws + WS_WAIN + (size_t)jl * 1536 * 1024), nullptr, S, E, krot);
                if (blockIdx.x >= 96) moe_convert_slice(F, L, L == 0 ? CV0_PRO : CV_C2(L), 24576 - (L == 0 ? CV0_PRO : CV_C2(L)), (int)blockIdx.x - 96, 160);
            }
            SEAM(pb + 1);
            if (IN(pb + 2)) {
#if ATT_NAIVE
                att_naive_phase(F, jl);
#else
                att_fast_phase(F, jl);
#endif
            }
            SEAM(pb + 2);
        } else {
            if (IN(pb + 1)) {
                pg8::StaticOrder S; S.init(nMt, 12, F.G, (int)blockIdx.x);
                pg8::EpiConvIn E{(bf16_t*)(ws + WS_BG), (bf16_t*)(ws + WS_U)};
                pg8::gemm_phase<pg8::EpiConvIn, pg8::StaticOrder, false, true, PG8_SP2>(F.lds, H, (const bf16_t*)(ws + WS_WCIN) + (size_t)jl * 3072 * 1024, nullptr, S, E, krot);
                if (with_ctx && blockIdx.x >= 192) moe_convert_slice(F, L, CV_C2(L), 24576 - CV_C2(L), (int)blockIdx.x - 192, 64);
            }
            SEAM(pb + 1);
            if (IN(pb + 2)) { conv_phase(F, jl, nrows); }
            SEAM(pb + 2);
        }
        if (IN(pb + 3)) {
            pg8::StaticOrder S; S.init(nMt, 4, F.G, (int)blockIdx.x);
            if ((L & 1) == 0) {
                pg8::EpiResid E{(bf16_t*)(ws + WS_X), modL, 2 * 1024, 1.0f / (pg8::SC_O * pg8::SC_W)};
                pg8::gemm_phase<pg8::EpiResid, pg8::StaticOrder, false, true, PG8_SP2, true>(F.lds, (const bf16_t*)H, (const bf16_t*)(ws + WS_WAOUT + (size_t)jl * 1024 * 1024), nullptr, S, E, krot);
            } else {
                pg8::EpiResid E{(bf16_t*)(ws + WS_X), modL, 2 * 1024, 1.0f};
                pg8::gemm_phase<pg8::EpiResid, pg8::StaticOrder, false, true, PG8_SP2>(F.lds, (const bf16_t*)H, (const bf16_t*)(ws + WS_WCOUT) + (size_t)jl * 1024 * 1024, nullptr, S, E, krot);
            }
            if (with_ctx && blockIdx.x >= 64) moe_convert_slice(F, L + 1, 0, CV_C1(L + 1), (int)blockIdx.x - 64, 192);
        }
        SEAM(pb + 3);
        if (IN(pb + 4)) {
            { n2_phase(F, L, nrows); __syncthreads(); } } SEAM(pb + 4);
        if (IN(pb + 5)) { tk_phase(F, with_ctx); } SEAM(pb + 5);
        if (IN(pb + 6)) {
            pg8::UpOrder S; S.init(F.G, (int)blockIdx.x, with_ctx);
            LAS unsigned* gtab = (LAS unsigned*)(F.lds + GTAB_OFF);
            const unsigned* IDX = (const unsigned*)(ws + WS_IDX);
            { int t_ = threadIdx.x; asm volatile("" : "+v"(t_));
              if (t_ < 256) { unsigned gv_[9]; pg8::Unit u;
#pragma unroll
                  for (int i = 0; i < 9; ++i) gv_[i] = S.next(i, u) ? IDX[(size_t)u.pm * 256 + t_] : 0u;
#pragma unroll
                  for (int i = 0; i < 9; ++i) gtab[i * 256 + t_] = gv_[i]; } }
            __syncthreads();
            pg8::EpiUp E{ws + WS_HID};
            pg8::gemm_phase<pg8::EpiUp, pg8::UpOrder, true, true, PG8_SP2, true>(F.lds, (const bf16_t*)(ws + WS_H), (const bf16_t*)(ws + WS_WUP + (size_t)L * 16 * 2048 * 1024), gtab, S, E, krot);
        }
        SEAM(pb + 6);
        if (IN(pb + 7)) {
            pg8::DnOrder S; S.init(F.G, (int)blockIdx.x, with_ctx);
            pg8::EpiDown E{ws + WS_Y, (const float*)(ws + WS_GATE), modL};
            pg8::gemm_phase<pg8::EpiDown, pg8::DnOrder, false, true, PG8_SP2, true>(F.lds, (const bf16_t*)(ws + WS_HID), (const bf16_t*)(ws + WS_WDN + (size_t)L * 16 * 1024 * 1024), nullptr, S, E, krot);
            if (with_ctx && blockIdx.x >= 128) moe_convert_slice(F, L + 1, CV_C1(L + 1), CV_C2(L + 1) - CV_C1(L + 1), (int)blockIdx.x - 128, 128);
        }
        SEAM(pb + 7);
    }
    if (IN(33)) {
        fin_phase(F); }
#undef IN
#undef SEAM
}

extern "C" void kernel_launch(void* const* d_in, const int* in_sizes, int n_in, void* d_out, int out_size, void* d_ws, size_t ws_size, hipStream_t stream) {
    static int grid = 0;
    if (grid == 0) {
        if (n_in != 23 || out_size != NLAT * D || ws_size < WS_END) { fprintf(stderr, "kernel_launch: unexpected shapes (n_in %d, out %d, ws %zu)\n", n_in, out_size, ws_size); grid = -1; return; }
        int dev = 0, cus = 0, per_cu = 0;
        if (hipGetDevice(&dev) != hipSuccess || hipDeviceGetAttribute(&cus, hipDeviceAttributeMultiprocessorCount, dev) != hipSuccess) { grid = -1; return; }
        if (hipFuncSetAttribute((const void*)mk_fwd, hipFuncAttributeMaxDynamicSharedMemorySize, LDS_BYTES) != hipSuccess) { fprintf(stderr, "kernel_launch: hipFuncSetAttribute failed\n"); grid = -1; return; }
        if (hipOccupancyMaxActiveBlocksPerMultiprocessor(&per_cu, (const void*)mk_fwd, 512, LDS_BYTES) != hipSuccess || per_cu < 1) fprintf(stderr, "kernel_launch: occupancy query reports %d\n", per_cu);
        (void)hipGetLastError();
        if (cus < 256) { fprintf(stderr, "kernel_launch: %d CUs; this kernel's static deals need 256 resident workgroups; nothing launched\n", cus); grid = -1; return; }
        grid = 256;
    }
    if (grid < 0) return;
    (void)hipMemsetAsync((char*)d_ws + WS_CTL, 0, CTL_ZERO_BYTES, stream);
    Args a{};
    for (int i = 0; i < 23; ++i) a.in[i] = (const float*)d_in[i];
    a.out = (float*)d_out; a.ws = (unsigned char*)d_ws;
#if MK_PER_PHASE
    for (int p = 0; p < N_PHASES; ++p) { a.ph_lo = p; a.ph_hi = p + 1; hipLaunchKernelGGL(mk_fwd, dim3(grid), dim3(512), LDS_BYTES, stream, a); }
#else
    a.ph_lo = 0; a.ph_hi = N_PHASES;
    hipLaunchKernelGGL(mk_fwd, dim3(grid), dim3(512), LDS_BYTES, stream, a);
#endif
    const hipError_t le = hipPeekAtLastError();
    if (le != hipSuccess) fprintf(stderr, "kernel_launch: launch failed: %s\n", hipGetErrorName(le));
}
```
